# Optimizing an MI355X kernel written in HIP

```python
import jax, jax.numpy as jnp
from jax import lax
import numpy as np

D_MODEL = 2048
BATCH = 4
SEQ = 4096
DEPTH = 1

HG_HEADS = 8
HG_DK = 128
HG_DV = 128
HG_K = HG_HEADS * HG_DK
HG_V = HG_HEADS * HG_DV
HGRN_CHUNK = 64
GM_GROUPS = 8
GM_CH = 128
GM_WIDTH = GM_GROUPS * GM_CH
GM_CHUNK = 128
MIX_WIDTH = HG_V + GM_WIDTH
IN_SPLITS = (HG_K, 2 * HG_K, 2 * HG_K + HG_V, 2 * HG_K + 2 * HG_V, 2 * HG_K + 2 * HG_V + GM_WIDTH)
IN_WIDTH = 2 * HG_K + 2 * HG_V + 2 * GM_WIDTH
N_EXPERTS = 32
TOP_K = 4
D_FF = 2048
SWIGLU_LIMIT = 7.0
SWIGLU_ALPHA = 1.702
MOE_BLOCK = 256
PLE_DIM = 256
RMS_EPS = 1e-6
LN_EPS = 1e-5

kernel_name = "hybrid_hgrn2_gmlp_moe_block"


def rms_norm(x, g):
    xf = x.astype(jnp.float32)
    y = xf * lax.rsqrt(jnp.mean(xf * xf, axis=-1, keepdims=True) + RMS_EPS)
    return (y * g.astype(jnp.float32)).astype(x.dtype)


def layer_norm(x, g, b):
    xf = x.astype(jnp.float32)
    mu = jnp.mean(xf, axis=-1, keepdims=True)
    xc = xf - mu
    y = xc * lax.rsqrt(jnp.mean(xc * xc, axis=-1, keepdims=True) + LN_EPS)
    return (y * g.astype(jnp.float32) + b.astype(jnp.float32)).astype(x.dtype)


def hgrn2_recurrence(q, f_logit, v, lb):
    B, S = q.shape[0], q.shape[1]
    n = S // HGRN_CHUNK
    q = jax.nn.silu(q.astype(jnp.float32))
    f = lb + (1.0 - lb) * jax.nn.sigmoid(f_logit.astype(jnp.float32))
    log_f = jnp.log(f)
    k = 1.0 - f

    def to_chunks(t):
        return t.reshape(B, n, HGRN_CHUNK, HG_HEADS, t.shape[-1]).transpose(1, 0, 3, 2, 4)

    causal = jnp.tril(jnp.ones((HGRN_CHUNK, HGRN_CHUNK), dtype=bool))

    def step(state, inp):
        qc, kc, vc, gc = inp
        b = jnp.cumsum(gc, axis=2)
        o_inter = jnp.einsum('bhtd,bhde->bhte', qc * jnp.exp(b), state)
        diff = b[:, :, :, None, :] - b[:, :, None, :, :]
        decay = jnp.exp(jnp.where(causal[:, :, None], diff, -jnp.inf))
        scores = jnp.einsum('bhtd,bhsd,bhtsd->bhts', qc, kc, decay)
        o = o_inter + jnp.einsum('bhts,bhse->bhte', scores, vc)
        b_last = b[:, :, -1:, :]
        new_state = jnp.exp(b_last[:, :, 0, :])[..., None] * state + jnp.einsum(
            'bhsd,bhse->bhde', kc * jnp.exp(b_last - b), vc)
        return new_state, o

    s0 = jnp.zeros((B, HG_HEADS, HG_DK, HG_DV), jnp.float32)
    _, o = lax.scan(step, s0, (to_chunks(q), to_chunks(k), to_chunks(v.astype(jnp.float32)), to_chunks(log_f)))
    return o.transpose(1, 0, 3, 2, 4).reshape(B, S, HG_HEADS, HG_DV)


def chunked_spatial_gating(u, v, ln_g, ln_b, w_s, b_s):
    B, S = u.shape[0], u.shape[1]
    n = S // GM_CHUNK
    u = jax.nn.gelu(u, approximate=False)
    v = layer_norm(jax.nn.gelu(v, approximate=False), ln_g, ln_b)
    vb = v.reshape(B, n, GM_CHUNK, GM_GROUPS, GM_CH)
    w = w_s * jnp.tril(jnp.ones((GM_CHUNK, GM_CHUNK), w_s.dtype))
    mixed = jnp.einsum('gts,bnsgc->bntgc', w, vb) + b_s.T[:, :, None]
    return u * mixed.reshape(B, S, GM_WIDTH)


def moe_ffn(h, w_router, b_router, w_gu, b_gu, w_dn, b_dn):
    T, D = h.shape
    logits = (h @ w_router + b_router).astype(jnp.float32)
    top_val, top_idx = lax.top_k(logits, TOP_K)
    gates = jax.nn.softmax(top_val, axis=-1).astype(h.dtype)
    A = T * TOP_K
    e_flat = top_idx.reshape(-1).astype(jnp.int32)
    tok_flat = jnp.arange(A, dtype=jnp.int32) // TOP_K
    g_flat = gates.reshape(-1)
    order = jnp.argsort(e_flat)
    e_sorted, tok_sorted, g_sorted = e_flat[order], tok_flat[order], g_flat[order]
    counts = jnp.zeros((N_EXPERTS,), jnp.int32).at[e_flat].add(1)
    starts = jnp.cumsum(counts) - counts
    padded = (counts + MOE_BLOCK - 1) // MOE_BLOCK * MOE_BLOCK
    pad_ends = jnp.cumsum(padded)
    pad_starts = pad_ends - padded
    dest = pad_starts[e_sorted] + (jnp.arange(A, dtype=jnp.int32) - starts[e_sorted])
    n_blocks = -(-A // MOE_BLOCK) + N_EXPERTS
    n_rows = n_blocks * MOE_BLOCK
    row_tok = jnp.zeros((n_rows,), jnp.int32).at[dest].set(tok_sorted)
    row_gate = jnp.zeros((n_rows,), h.dtype).at[dest].set(g_sorted)
    block_start = jnp.arange(n_blocks, dtype=jnp.int32) * MOE_BLOCK
    block_expert = jnp.minimum(jnp.searchsorted(pad_ends, block_start, side='right'), N_EXPERTS - 1)

    def expert_block(args):
        toks, gts, e = args
        xb = h[toks]
        gu = xb @ w_gu[e] + b_gu[e]
        gate = jnp.minimum(gu[:, 0::2], SWIGLU_LIMIT)
        up = jnp.clip(gu[:, 1::2], -SWIGLU_LIMIT, SWIGLU_LIMIT)
        act = (up + 1.0) * gate * jax.nn.sigmoid(SWIGLU_ALPHA * gate)
        y = act @ w_dn[e] + b_dn[e]
        return y * gts[:, None]

    ys = lax.map(expert_block, (row_tok.reshape(n_blocks, MOE_BLOCK),
                                row_gate.reshape(n_blocks, MOE_BLOCK), block_expert))
    return jax.ops.segment_sum(ys.reshape(n_rows, D), row_tok, num_segments=T)


def setup_inputs(seed: int = 0) -> dict:
    key = jax.random.key(seed)
    ks = jax.random.split(key, 24)
    f32 = jnp.float32
    nrm = lambda k, s: jax.random.normal(k, s, f32)
    L = DEPTH
    return {
        "x": nrm(ks[0], (BATCH, SEQ, D_MODEL)),
        "p": nrm(ks[1], (DEPTH, BATCH, SEQ, PLE_DIM)),
        "norm_mix": 1.0 + 0.02 * nrm(ks[2], (L, D_MODEL)),
        "w_in": nrm(ks[3], (L, D_MODEL, IN_WIDTH)) * D_MODEL ** -0.5,
        "lb_logits": 0.5 * nrm(ks[4], (DEPTH + 1, HG_K)),
        "hgrn_out_norm": 1.0 + 0.02 * nrm(ks[5], (L, HG_V)),
        "gmlp_ln_g": 1.0 + 0.02 * nrm(ks[6], (L, GM_WIDTH)),
        "gmlp_ln_b": 0.02 * nrm(ks[7], (L, GM_WIDTH)),
        "w_spatial": nrm(ks[8], (L, GM_GROUPS, GM_CHUNK, GM_CHUNK)) * GM_CHUNK ** -0.5,
        "b_spatial": 1.0 + 0.02 * nrm(ks[9], (L, GM_GROUPS, GM_CHUNK)),
        "w_out": nrm(ks[10], (L, MIX_WIDTH, D_MODEL)) * MIX_WIDTH ** -0.5,
        "norm_ffn": 1.0 + 0.02 * nrm(ks[11], (L, D_MODEL)),
        "w_router": nrm(ks[12], (L, D_MODEL, N_EXPERTS)) * D_MODEL ** -0.5,
        "b_router": 0.01 * nrm(ks[13], (L, N_EXPERTS)),
        "w_gate_up": nrm(ks[14], (L, N_EXPERTS, D_MODEL, 2 * D_FF)) * D_MODEL ** -0.5,
        "b_gate_up": 0.02 * nrm(ks[15], (L, N_EXPERTS, 2 * D_FF)),
        "w_down": nrm(ks[16], (L, N_EXPERTS, D_FF, D_MODEL)) * D_FF ** -0.5,
        "b_down": 0.02 * nrm(ks[17], (L, N_EXPERTS, D_MODEL)),
        "norm_ple": 1.0 + 0.02 * nrm(ks[18], (L, D_MODEL)),
        "w_ple_gate": nrm(ks[19], (L, D_MODEL, D_MODEL)) * D_MODEL ** -0.5,
        "w_ple_proj": nrm(ks[20], (L, PLE_DIM, D_MODEL)) * PLE_DIM ** -0.5,
        "norm_final": 1.0 + 0.02 * nrm(ks[21], (D_MODEL,)),
    }


def reference(x, p, norm_mix, w_in, lb_logits, hgrn_out_norm, gmlp_ln_g, gmlp_ln_b, w_spatial,
              b_spatial, w_out, norm_ffn, w_router, b_router, w_gate_up, b_gate_up, w_down, b_down,
              norm_ple, w_ple_gate, w_ple_proj, norm_final):
    B, S, D = x.shape
    lower_bounds = jnp.cumsum(jax.nn.softmax(lb_logits.astype(jnp.float32), axis=0), axis=0)
    for i in range(DEPTH):
        h = rms_norm(x, norm_mix[i])
        z = h @ w_in[i]
        q, f_logit, v_in, o_gate, u, v = jnp.split(z, IN_SPLITS, axis=-1)
        lb = lower_bounds[i].reshape(HG_HEADS, HG_DK)
        o = hgrn2_recurrence(q.reshape(B, S, HG_HEADS, HG_DK), f_logit.reshape(B, S, HG_HEADS, HG_DK),
                             v_in.reshape(B, S, HG_HEADS, HG_DV), lb)
        o = rms_norm(o, hgrn_out_norm[i].reshape(HG_HEADS, HG_DV)).reshape(B, S, HG_V).astype(x.dtype)
        o = o * jax.nn.sigmoid(o_gate)
        sg = chunked_spatial_gating(u, v, gmlp_ln_g[i], gmlp_ln_b[i], w_spatial[i], b_spatial[i])
        x = x + jnp.concatenate([o, sg], axis=-1) @ w_out[i]
        h = rms_norm(x, norm_ffn[i])
        x = x + moe_ffn(h.reshape(B * S, D), w_router[i], b_router[i], w_gate_up[i], b_gate_up[i],
                        w_down[i], b_down[i]).reshape(B, S, D)
        gate = jax.nn.sigmoid(rms_norm(x, norm_ple[i]) @ w_ple_gate[i])
        x = x + gate * (p[i] @ w_ple_proj[i])
    return rms_norm(x, norm_final)
```

```cpp
#include <hip/hip_runtime.h>
#include <cstdio>
#include <cstdint>

constexpr int BATCH = 4, SEQ = 4096, T = BATCH * SEQ, D = 2048;
constexpr int HG_H = 8, HG_DK = 128, HG_DV = 128, HG_K = 1024, HG_V = 1024;
constexpr int GM_G = 8, GM_CH = 128, GM_W = 1024, GM_CHUNK = 128;
constexpr int IN_W = 6144;
constexpr int ZQ = 0, ZF = 1024, ZI = 2048, ZG = 3072, ZU = 4096, ZV = 5120;
constexpr int NE = 32, TOPK = 4, DFF = 2048;
constexpr int PLE = 256;
constexpr float RMS_EPS = 1e-6f, LN_EPS = 1e-5f;
constexpr int MT = 128;
constexpr int MAXTILES = 576, RMAX = MAXTILES * MT;

__device__ __forceinline__ float gelu_erf(float x) { return 0.5f * x * (1.f + erff(x * 0.70710678118f)); }
__device__ __forceinline__ float sigmoidf(float x) { return 1.f / (1.f + expf(-x)); }
__device__ __forceinline__ float wave_sum(float v) {
#pragma unroll
    for (int o = 32; o >= 1; o >>= 1) v += __shfl_xor(v, o);
    return v;
}

#define LAS __attribute__((address_space(3)))
#define GAS __attribute__((address_space(1)))
typedef unsigned short bf16_t;
typedef short bf16x8 __attribute__((ext_vector_type(8)));
typedef float f32x4 __attribute__((ext_vector_type(4)));
typedef float f32x2 __attribute__((ext_vector_type(2)));
typedef unsigned u32x4 __attribute__((ext_vector_type(4)));
typedef unsigned u32x2 __attribute__((ext_vector_type(2)));
typedef GAS unsigned gu32;
#define RLX_AGENT __ATOMIC_RELAXED, __HIP_MEMORY_SCOPE_AGENT
#define LDS_WAIT() asm volatile("s_waitcnt lgkmcnt(0)" ::: "memory")
#define VM_WAIT() asm volatile("s_waitcnt vmcnt(0)" ::: "memory")

typedef __bf16 bf16x2_t __attribute__((ext_vector_type(2)));
__device__ __forceinline__ unsigned cvt_pk_bf16(float lo, float hi) { f32x2 v = {lo, hi}; bf16x2_t b = __builtin_convertvector(v, bf16x2_t); return __builtin_bit_cast(unsigned, b); }
__device__ __forceinline__ float bf2f(unsigned short b) { return __uint_as_float(((unsigned)b) << 16); }
__device__ __forceinline__ float bflo(unsigned w) { return __uint_as_float(w << 16); }
__device__ __forceinline__ float bfhi(unsigned w) { return __uint_as_float(w & 0xffff0000u); }
__device__ __forceinline__ unsigned short f2bf(float f) { return (unsigned short)__builtin_bit_cast(unsigned short, (__bf16)f); }
__device__ __forceinline__ float fast_sigmoid(float x) { return __builtin_amdgcn_rcpf(1.f + __builtin_amdgcn_exp2f(-1.44269504f * x)); }

__device__ __forceinline__ float fast_exp(float x) { return __builtin_amdgcn_exp2f(1.44269504f * x); }
__device__ __forceinline__ float fast_log(float x) { return 0.69314718f * __builtin_amdgcn_logf(x); }
__device__ __forceinline__ float gelu_fast(float v) {
    const float av = fabsf(v), t = __builtin_amdgcn_rcpf(1.0f + 0.2316418882f * av);
    float q = t * 0.5307027145f + (-0.7265760135f); q = q * t + 0.7107068705f; q = q * t + (-0.142248368f); q = q * t + 0.127414796f; q = q * t;
    const float e = __builtin_amdgcn_exp2f((v * v) * (-0.72134752044f)), m = v * (q * e);
    return v < 0.f ? m : v - m;
}
__device__ __forceinline__ float ld_agent_f(const float* p) { return __uint_as_float(__hip_atomic_load((const unsigned*)p, __ATOMIC_RELAXED, __HIP_MEMORY_SCOPE_AGENT)); }
__device__ __forceinline__ int ld_agent_i(const int* p) { return (int)__hip_atomic_load((const unsigned*)p, __ATOMIC_RELAXED, __HIP_MEMORY_SCOPE_AGENT); }
__device__ __forceinline__ unsigned pack4_fp8(float a, float b, float c, float d) { int r = __builtin_amdgcn_cvt_pk_fp8_f32(a, b, 0, false); r = __builtin_amdgcn_cvt_pk_fp8_f32(c, d, r, true); return (unsigned)r; }
__device__ __forceinline__ float clamp_f8(float v) { return __builtin_amdgcn_fmed3f(v, -440.f, 440.f); }
__device__ __forceinline__ unsigned pack4_fp8c(float a, float b, float c, float d) { return pack4_fp8(clamp_f8(a), clamp_f8(b), clamp_f8(c), clamp_f8(d)); }
typedef float f32x2u __attribute__((ext_vector_type(2)));
__device__ __forceinline__ void unpack4_fp8(unsigned w, float (&o)[4]) { const f32x2u lo = __builtin_amdgcn_cvt_pk_f32_fp8((int)w, false), hi = __builtin_amdgcn_cvt_pk_f32_fp8((int)w, true); o[0] = lo[0]; o[1] = lo[1]; o[2] = hi[0]; o[3] = hi[1]; }
#ifndef MOE_FP8
#define MOE_FP8 1
#endif
constexpr float F8_WSCALE = 256.f, F8_XSCALE = 16.f, F8_ASCALE = 4.f, F8_YSCALE = 64.f, F8_MSCALE = 8.f;
#ifndef OUT_FP8
#define OUT_FP8 0
#endif
#ifndef F8_MFMA_SCALE
#define F8_MFMA_SCALE 0
#endif
typedef int i32x8 __attribute__((ext_vector_type(8)));
typedef int i32x4 __attribute__((ext_vector_type(4)));
#ifndef X1_LO
#define X1_LO 0
#endif
#ifndef MOE_WGM
#define MOE_WGM 4
#endif
constexpr int LISTCAP = T;
constexpr int MOE_MAXTILES = 288;
constexpr int MOE_RMAX = MOE_MAXTILES * 256;

namespace pg8 {
constexpr int BM = 256, BK = 64, HALF = 128, HTB = HALF * BK * 2  , STAGE_BYTES = 8 * HTB, NXCD = 8, WGM = 8;
__host__ __device__ __forceinline__ int lds_byte(int r, int c) { const int st = (r >> 4) * 2 + (c >> 5), rr = r & 15, cc = c & 31, ob = rr * 64 + cc * 2; return st * 1024 + (ob ^ (((ob >> 9) & 1) << 5)); }
__host__ __device__ __forceinline__ void stage_rc(int b, int& R, int& C) { const int st = b / 1024, sb = b % 1024, swz = sb ^ (((sb >> 9) & 1) << 5); R = (st >> 1) * 16 + swz / 64; C = (st & 1) * 32 + (swz % 64) / 2; }
__host__ __device__ __forceinline__ int perm32(int rho) { const int n = rho >> 4, i = rho & 15; return 8 * (i >> 2) + 4 * n + (i & 3); }

struct Unit { int pm, pn, e, gbase; };
struct Gemm { const bf16_t* A; const bf16_t* Bt; const int* rowidx; long long strideE; int K; int maxrow; };

__device__ __forceinline__ bool tile_order(int i, int G, int c, int nM, int nN, int& pm, int& pn, int wgm = WGM) {
    const int nwg = nM * nN; const long L = (long)i * G + c; if (L >= nwg) return false;
    int wgid = (int)L; { const int q = nwg / NXCD, r = nwg % NXCD, xcd = wgid % NXCD, off = wgid / NXCD; wgid = (xcd < r ? xcd * (q + 1) : r * (q + 1) + (xcd - r) * q) + off; }
    const int nig = wgm * nN, gid = wgid / nig, fm = gid * wgm, gsz = (nM - fm) < wgm ? (nM - fm) : wgm;
    pm = fm + ((wgid % nig) % gsz); pn = (wgid % nig) / gsz; return true;
}
struct StaticOrder {
    int nM, nN, G, c, i0, nr, wgm;
    __device__ void init(int M, int N, int G_, int c_, int i0_ = 0, int nr_ = 1 << 30, int wgm_ = WGM) { nM = M / BM; nN = N / BM; G = G_; c = c_; i0 = i0_; nr = nr_; wgm = wgm_; }
    __device__ __forceinline__ bool next(int i, Unit& u) const { u.e = 0; u.gbase = 0; if (i >= nr) return false; return tile_order(i + i0, G, c, nM, nN, u.pm, u.pn, wgm); }
};
struct MoeOrder {
    int nM, nN, G, c; const LAS int* tile_e; const LAS int* tstart;
    __device__ __forceinline__ bool next(int i, Unit& u) const {
        if (!tile_order(i, G, c, nM, nN, u.pm, u.pn, MOE_WGM)) return false;
        const int e = __builtin_amdgcn_readfirstlane(tile_e[u.pm]); u.e = e;
        u.gbase = e * LISTCAP + (u.pm - __builtin_amdgcn_readfirstlane(tstart[e])) * BM; return true;
    }
};

struct EpiBf16 {
    static constexpr bool ACC_INIT = false;
    bf16_t* O; int ldc;
    __device__ __forceinline__ void operator()(const f32x4 (&acc)[2][2][4][2], const Unit& u, int wr, int wc, int fr, int fq) const {
        bf16_t* base = O + (size_t)(u.pm * BM + wr * 64 + fr) * ldc + u.pn * BM + wc * 32 + 8 * fq;
#pragma unroll
        for (int ai = 0; ai < 2; ++ai)
#pragma unroll
            for (int m = 0; m < 4; ++m) { bf16_t* rowp = base + (size_t)(ai * HALF + m * 16) * ldc;
#pragma unroll
                for (int bj = 0; bj < 2; ++bj) { const f32x4 v0 = acc[ai][bj][m][0], v1 = acc[ai][bj][m][1];
                    u32x4 w; w.x = cvt_pk_bf16(v0[0], v0[1]); w.y = cvt_pk_bf16(v0[2], v0[3]); w.z = cvt_pk_bf16(v1[0], v1[1]); w.w = cvt_pk_bf16(v1[2], v1[3]);
                    *(u32x4*)(rowp + bj * HALF) = w; } }
    }
};
struct EpiResF32Bf16 {
    static constexpr bool ACC_INIT = true;
    const float* res; bf16_t* XH; bf16_t* XL; bf16_t* XB;
    __device__ __forceinline__ void init(f32x4 (&acc)[2][2][4][2], const Unit& u, int wr, int wc, int fr, int fq) const {
        const size_t o0 = (size_t)(u.pm * BM + wr * 64 + fr) * D + u.pn * BM + wc * 32 + 8 * fq;
#pragma unroll
        for (int ai = 0; ai < 2; ++ai)
#pragma unroll
            for (int m = 0; m < 4; ++m)
#pragma unroll
                for (int bj = 0; bj < 2; ++bj) { const size_t o = o0 + (size_t)(ai * HALF + m * 16) * D + bj * HALF; acc[ai][bj][m][0] = *(const f32x4*)(res + o); acc[ai][bj][m][1] = *(const f32x4*)(res + o + 4); }
    }
    __device__ __forceinline__ void operator()(const f32x4 (&acc)[2][2][4][2], const Unit& u, int wr, int wc, int fr, int fq) const {
        const size_t o0 = (size_t)(u.pm * BM + wr * 64 + fr) * D + u.pn * BM + wc * 32 + 8 * fq;
#pragma unroll
        for (int ai = 0; ai < 2; ++ai)
#pragma unroll
            for (int m = 0; m < 4; ++m) { const size_t o = o0 + (size_t)(ai * HALF + m * 16) * D;
#pragma unroll
                for (int bj = 0; bj < 2; ++bj) {
                    const f32x4 v0 = acc[ai][bj][m][0], v1 = acc[ai][bj][m][1];
                    u32x4 wh; wh.x = cvt_pk_bf16(v0[0], v0[1]); wh.y = cvt_pk_bf16(v0[2], v0[3]); wh.z = cvt_pk_bf16(v1[0], v1[1]); wh.w = cvt_pk_bf16(v1[2], v1[3]);
                    u32x4 wl; wl.x = cvt_pk_bf16(v0[0] - bflo(wh.x), v0[1] - bfhi(wh.x)); wl.y = cvt_pk_bf16(v0[2] - bflo(wh.y), v0[3] - bfhi(wh.y)); wl.z = cvt_pk_bf16(v1[0] - bflo(wh.z), v1[1] - bfhi(wh.z)); wl.w = cvt_pk_bf16(v1[2] - bflo(wh.w), v1[3] - bfhi(wh.w));
                    *(u32x4*)(XH + o + bj * HALF) = wh; if (X1_LO) *(u32x4*)(XL + o + bj * HALF) = wl;
#if MOE_FP8
                    u32x2 w; w.x = pack4_fp8c(v0[0] * F8_XSCALE, v0[1] * F8_XSCALE, v0[2] * F8_XSCALE, v0[3] * F8_XSCALE); w.y = pack4_fp8c(v1[0] * F8_XSCALE, v1[1] * F8_XSCALE, v1[2] * F8_XSCALE, v1[3] * F8_XSCALE);
                    *(u32x2*)((unsigned char*)XB + o + bj * HALF) = w; }
#endif
            }
    }
};
struct EpiSwiglu {
    static constexpr bool ACC_INIT = false;
    bf16_t* ACT; const float* rs; const float* bgu;
    __device__ __forceinline__ void operator()(const f32x4 (&acc)[2][2][4][2], const Unit& u, int wr, int wc, int fr, int fq) const {
        const int a0 = u.pn * HALF + wc * 32 + 8 * fq;
        const float* bp = bgu + (size_t)u.e * (2 * DFF) + 2 * a0;
        const f32x4 b0 = *(const f32x4*)bp, b1 = *(const f32x4*)(bp + 4), b2 = *(const f32x4*)(bp + 8), b3 = *(const f32x4*)(bp + 12);
        const float bg[8] = {b0[0], b0[2], b1[0], b1[2], b2[0], b2[2], b3[0], b3[2]}, bu[8] = {b0[1], b0[3], b1[1], b1[3], b2[1], b2[3], b3[1], b3[3]};
        const float* rsp = rs + u.gbase + wr * 64 + fr;
        bf16_t* base = ACT + (size_t)(u.pm * BM + wr * 64 + fr) * DFF + a0;
        float scv[2][4];
#pragma unroll
        for (int ai = 0; ai < 2; ++ai)
#pragma unroll
            for (int m = 0; m < 4; ++m) scv[ai][m] = rsp[ai * HALF + m * 16];
#pragma unroll
        for (int ai = 0; ai < 2; ++ai)
#pragma unroll
            for (int m = 0; m < 4; ++m) { const float sc = scv[ai][m] * (MOE_FP8 ? 1.f / (F8_WSCALE * F8_XSCALE) : 1.f); float a[8];
#pragma unroll
                for (int n = 0; n < 2; ++n)
#pragma unroll
                    for (int j = 0; j < 4; ++j) { const float g = fminf(acc[ai][0][m][n][j] * sc + bg[4 * n + j], 7.f), up = fminf(fmaxf(acc[ai][1][m][n][j] * sc + bu[4 * n + j], -7.f), 7.f);
                        a[4 * n + j] = (up + 1.f) * g * fast_sigmoid(1.702f * g); }
#if MOE_FP8
                u32x2 w; w.x = pack4_fp8c(a[0] * F8_ASCALE, a[1] * F8_ASCALE, a[2] * F8_ASCALE, a[3] * F8_ASCALE); w.y = pack4_fp8c(a[4] * F8_ASCALE, a[5] * F8_ASCALE, a[6] * F8_ASCALE, a[7] * F8_ASCALE);
                *(u32x2*)((unsigned char*)ACT + (size_t)(u.pm * BM + wr * 64 + fr + ai * HALF + m * 16) * DFF + a0) = w; }
#else
                u32x4 w; w.x = cvt_pk_bf16(a[0], a[1]); w.y = cvt_pk_bf16(a[2], a[3]); w.z = cvt_pk_bf16(a[4], a[5]); w.w = cvt_pk_bf16(a[6], a[7]);
                *(u32x4*)(base + (size_t)(ai * HALF + m * 16) * DFF) = w; }
#endif
    }
};
struct EpiDown {
    static constexpr bool ACC_INIT = false;
    bf16_t* Y; const float* gt; const float* bdn;
    __device__ __forceinline__ void operator()(const f32x4 (&acc)[2][2][4][2], const Unit& u, int wr, int wc, int fr, int fq) const {
        const int c0 = u.pn * BM + wc * 32 + 8 * fq;
        const float* bp = bdn + (size_t)u.e * D + c0;
        f32x4 bv[2][2];
#pragma unroll
        for (int bj = 0; bj < 2; ++bj) { bv[bj][0] = *(const f32x4*)(bp + bj * HALF); bv[bj][1] = *(const f32x4*)(bp + bj * HALF + 4); }
        const float* gp = gt + u.gbase + wr * 64 + fr;
        bf16_t* base = Y + (size_t)(u.pm * BM + wr * 64 + fr) * D + c0;
        float ggv[2][4];
#pragma unroll
        for (int ai = 0; ai < 2; ++ai)
#pragma unroll
            for (int m = 0; m < 4; ++m) ggv[ai][m] = gp[ai * HALF + m * 16];
#pragma unroll
        for (int ai = 0; ai < 2; ++ai)
#pragma unroll
            for (int m = 0; m < 4; ++m) { const float gg = ggv[ai][m]; bf16_t* rowp = base + (size_t)(ai * HALF + m * 16) * D;
#pragma unroll
                for (int bj = 0; bj < 2; ++bj) { const float ds = MOE_FP8 ? 1.f / (F8_WSCALE * F8_ASCALE) : 1.f; const f32x4 v0 = (acc[ai][bj][m][0] * ds + bv[bj][0]) * gg, v1 = (acc[ai][bj][m][1] * ds + bv[bj][1]) * gg;
#if MOE_FP8
                    u32x2 w; w.x = pack4_fp8c(v0[0] * F8_YSCALE, v0[1] * F8_YSCALE, v0[2] * F8_YSCALE, v0[3] * F8_YSCALE); w.y = pack4_fp8c(v1[0] * F8_YSCALE, v1[1] * F8_YSCALE, v1[2] * F8_YSCALE, v1[3] * F8_YSCALE);
                    *(u32x2*)((unsigned char*)Y + (size_t)(u.pm * BM + wr * 64 + fr + ai * HALF + m * 16) * D + c0 + bj * HALF) = w; } }
#else
                    u32x4 w; w.x = cvt_pk_bf16(v0[0], v0[1]); w.y = cvt_pk_bf16(v0[2], v0[3]); w.z = cvt_pk_bf16(v1[0], v1[1]); w.w = cvt_pk_bf16(v1[2], v1[3]);
                    *(u32x4*)(rowp + bj * HALF) = w; } }
#endif
    }
};
struct EpiPleGate {
    static constexpr bool ACC_INIT = false;
    const bf16_t* X2B; const float* rstd2; const bf16_t* PLEB; bf16_t* X3B; float* ssq;
    __device__ __forceinline__ void operator()(const f32x4 (&acc)[2][2][4][2], const Unit& u, int wr, int wc, int fr, int fq) const {
        const int row0 = u.pm * BM + wr * 64 + fr;
        const size_t o0 = (size_t)row0 * D + u.pn * BM + wc * 32 + 8 * fq;
#pragma unroll
        for (int ai = 0; ai < 2; ++ai) {
            u32x4 xw[4][2], pw[4][2]; float rsv[4];
#pragma unroll
            for (int m = 0; m < 4; ++m) { rsv[m] = rstd2[row0 + ai * HALF + m * 16];
#pragma unroll
                for (int bj = 0; bj < 2; ++bj) { const size_t o = o0 + (size_t)(ai * HALF + m * 16) * D + bj * HALF; xw[m][bj] = *(const u32x4*)(X2B + o); pw[m][bj] = *(const u32x4*)(PLEB + o); } }
#pragma unroll
            for (int m = 0; m < 4; ++m) { const size_t o = o0 + (size_t)(ai * HALF + m * 16) * D; const float rs = rsv[m] * (MOE_FP8 ? 1.f / (F8_WSCALE * F8_XSCALE) : 1.f); float s = 0.f;
#pragma unroll
                for (int bj = 0; bj < 2; ++bj) { const u32x4 xq = xw[m][bj], pq = pw[m][bj];
                    const float xv[8] = {bflo(xq.x), bfhi(xq.x), bflo(xq.y), bfhi(xq.y), bflo(xq.z), bfhi(xq.z), bflo(xq.w), bfhi(xq.w)};
                    const float pl[8] = {bflo(pq.x), bfhi(pq.x), bflo(pq.y), bfhi(pq.y), bflo(pq.z), bfhi(pq.z), bflo(pq.w), bfhi(pq.w)};
                    float v[8];
#pragma unroll
                    for (int j = 0; j < 4; ++j) { v[j] = xv[j] + fast_sigmoid(acc[ai][bj][m][0][j] * rs) * pl[j]; v[4 + j] = xv[4 + j] + fast_sigmoid(acc[ai][bj][m][1][j] * rs) * pl[4 + j]; s += v[j] * v[j] + v[4 + j] * v[4 + j]; }
                    u32x4 w; w.x = cvt_pk_bf16(v[0], v[1]); w.y = cvt_pk_bf16(v[2], v[3]); w.z = cvt_pk_bf16(v[4], v[5]); w.w = cvt_pk_bf16(v[6], v[7]);
                    *(u32x4*)(X3B + o + bj * HALF) = w; }
                s += __shfl_xor(s, 16); s += __shfl_xor(s, 32);
                if (fq == 0) atomicAdd(ssq + row0 + ai * HALF + m * 16, s); }
            asm volatile("" ::: "memory"); }
    }
};

struct EpiPleGateNorm {
    static constexpr bool ACC_INIT = false;
    const bf16_t* X2B; const float* rstd2; const bf16_t* PLEB; float* out; float* ssq; unsigned* pcnt; const float* gfin;
    __device__ __forceinline__ void operator()(f32x4 (&acc)[2][2][4][2], const Unit& u, int wr, int wc, int fr, int fq) const {
        const int row0 = u.pm * BM + wr * 64 + fr;
        const size_t o0 = (size_t)row0 * D + u.pn * BM + wc * 32 + 8 * fq;
#pragma unroll
        for (int ai = 0; ai < 2; ++ai) {
            u32x4 xw[4][2], pw[4][2]; float rsv[4];
#pragma unroll
            for (int m = 0; m < 4; ++m) { rsv[m] = rstd2[row0 + ai * HALF + m * 16];
#pragma unroll
                for (int bj = 0; bj < 2; ++bj) { const size_t o = o0 + (size_t)(ai * HALF + m * 16) * D + bj * HALF; xw[m][bj] = *(const u32x4*)(X2B + o); pw[m][bj] = *(const u32x4*)(PLEB + o); } }
#pragma unroll
            for (int m = 0; m < 4; ++m) { const float rs = rsv[m] * (MOE_FP8 ? 1.f / (F8_WSCALE * F8_XSCALE) : 1.f); float s = 0.f;
#pragma unroll
                for (int bj = 0; bj < 2; ++bj) { const u32x4 xq = xw[m][bj], pq = pw[m][bj];
                    const float xv[8] = {bflo(xq.x), bfhi(xq.x), bflo(xq.y), bfhi(xq.y), bflo(xq.z), bfhi(xq.z), bflo(xq.w), bfhi(xq.w)};
                    const float pl[8] = {bflo(pq.x), bfhi(pq.x), bflo(pq.y), bfhi(pq.y), bflo(pq.z), bfhi(pq.z), bflo(pq.w), bfhi(pq.w)};
#pragma unroll
                    for (int j = 0; j < 4; ++j) { const float v0 = xv[j] + fast_sigmoid(acc[ai][bj][m][0][j] * rs) * pl[j], v1 = xv[4 + j] + fast_sigmoid(acc[ai][bj][m][1][j] * rs) * pl[4 + j];
                        acc[ai][bj][m][0][j] = v0; acc[ai][bj][m][1][j] = v1; s += v0 * v0 + v1 * v1; } }
                s += __shfl_xor(s, 16); s += __shfl_xor(s, 32);
                if (fq == 0) atomicAdd(ssq + row0 + ai * HALF + m * 16, s); }
            asm volatile("" ::: "memory"); }
        asm volatile("s_waitcnt vmcnt(0)" ::: "memory");
        __builtin_amdgcn_s_barrier();
        if (threadIdx.x == 0) {
            unsigned* pc = pcnt + 64 * u.pm;
            (void)__hip_atomic_fetch_add(pc, 1u, __ATOMIC_RELAXED, __HIP_MEMORY_SCOPE_AGENT);
            for (unsigned sp = 0; __hip_atomic_load(pc, __ATOMIC_RELAXED, __HIP_MEMORY_SCOPE_AGENT) < (unsigned)(D / BM) && sp < (1u << 20); ++sp) __builtin_amdgcn_s_sleep(1);
        }
        asm volatile("" ::: "memory"); __builtin_amdgcn_s_barrier(); asm volatile("" ::: "memory");
        const int c0 = u.pn * BM + wc * 32 + 8 * fq;
        f32x4 gv[2][2];
#pragma unroll
        for (int bj = 0; bj < 2; ++bj) { gv[bj][0] = *(const f32x4*)(gfin + c0 + bj * HALF); gv[bj][1] = *(const f32x4*)(gfin + c0 + bj * HALF + 4); }
        float rr[2][4];
#pragma unroll
        for (int ai = 0; ai < 2; ++ai)
#pragma unroll
            for (int m = 0; m < 4; ++m) rr[ai][m] = rsqrtf(ld_agent_f(ssq + row0 + ai * HALF + m * 16) * (1.f / D) + RMS_EPS);
#pragma unroll
        for (int ai = 0; ai < 2; ++ai)
#pragma unroll
            for (int m = 0; m < 4; ++m) { const size_t o = o0 + (size_t)(ai * HALF + m * 16) * D;
#pragma unroll
                for (int bj = 0; bj < 2; ++bj) { *(f32x4*)(out + o + bj * HALF) = acc[ai][bj][m][0] * rr[ai][m] * gv[bj][0]; *(f32x4*)(out + o + bj * HALF + 4) = acc[ai][bj][m][1] * rr[ai][m] * gv[bj][1]; } }
    }
};

template <class Epi, class Sched, bool GATHER, bool FP8 = false>
__device__ __forceinline__ void gemm_phase(LAS unsigned char* lds, const Gemm g, const Sched& S, const Epi& E) {
    const int tid = threadIdx.x, wid = __builtin_amdgcn_readfirstlane(tid >> 6), lane = tid & 63, wr = wid >> 2, wc = wid & 3, fr = lane & 15, fq = lane >> 4;
    const int K = g.K, nt = K / BK;
    unsigned voffB[2];
#pragma unroll
    for (int i = 0; i < 2; ++i) { int R, C; stage_rc(tid * 16 + i * 8192, R, C); const int Rb = (R & ~31) + perm32(R & 31); voffB[i] = (unsigned)(Rb * K + C) * 2u; }
    const size_t kstep = (size_t)(BK * 2);
    const size_t hstep = (size_t)HALF * K * 2;
    const size_t tstep = 2 * hstep;
    const unsigned ldsw = (unsigned)wid * 1024u;
    const int aoff = lds_byte(wr * 64 + fr, fq * 8), boff = lds_byte(wc * 32 + fr, fq * 8);
    const char* Ab = (const char*)g.A;
#define PG8_SA(b, h) (((b) * 2 + (h)) * HTB)
#define PG8_SB(b, h) ((4 + (b) * 2 + (h)) * HTB)
#define PG8_STAGE(bufoff, gbase, voff) do { _Pragma("unroll") for (int _i = 0; _i < 2; ++_i) \
        __builtin_amdgcn_global_load_lds((const unsigned*)((const char*)(gbase) + (voff)[_i]), (LAS unsigned*)(lds + (bufoff) + ldsw + _i * 8192), 16, 0, 0); } while (0)
#define PG8_STAGE_A(bufoff, VO, h, koff) do { const char* _ab = Ab + (size_t)(koff); asm volatile("" : "+s"(_ab)); _Pragma("unroll") for (int _i = 0; _i < 2; ++_i) \
        __builtin_amdgcn_global_load_lds((const unsigned*)(_ab + (VO)[h][_i]), (LAS unsigned*)(lds + (bufoff) + ldsw + _i * 8192), 16, 0, 0); } while (0)
#define PG8_LOAD_VO(VO, U) do { int _t = tid; asm volatile("" : "+v"(_t)); _Pragma("unroll") for (int _i = 0; _i < 2; ++_i) { int _R, _C; stage_rc(_t * 16 + _i * 8192, _R, _C); _Pragma("unroll") for (int _h = 0; _h < 2; ++_h) { \
        unsigned _row; if (GATHER) { _row = (unsigned)g.rowidx[(U).gbase + _h * HALF + _R]; _row = _row < (unsigned)g.maxrow ? _row : (unsigned)g.maxrow; } else _row = (unsigned)((U).pm * BM + _h * HALF + _R); \
        (VO)[_h][_i] = (_row * (unsigned)K + (unsigned)_C) * 2u; } } } while (0)
#define PG8_LDA(dst, b, h) do { _Pragma("unroll") for (int m = 0; m < 4; ++m) { if constexpr (FP8) { const i32x4 _l = *(const LAS i32x4*)(lds + PG8_SA(b, h) + aoff + m * 2048), _h = *(const LAS i32x4*)(lds + PG8_SA(b, h) + aoff + m * 2048 + 1024); \
            dst##8[m] = __builtin_shufflevector(_l, _h, 0, 1, 2, 3, 4, 5, 6, 7); } else { _Pragma("unroll") for (int k = 0; k < 2; ++k) dst[m][k] = *(const LAS bf16x8*)(lds + PG8_SA(b, h) + aoff + m * 2048 + k * 1024); } } } while (0)
#define PG8_LDB(dst, b, h) do { _Pragma("unroll") for (int n = 0; n < 2; ++n) { if constexpr (FP8) { const i32x4 _l = *(const LAS i32x4*)(lds + PG8_SB(b, h) + boff + n * 2048), _h = *(const LAS i32x4*)(lds + PG8_SB(b, h) + boff + n * 2048 + 1024); \
            dst##8[n] = __builtin_shufflevector(_l, _h, 0, 1, 2, 3, 4, 5, 6, 7); } else { _Pragma("unroll") for (int k = 0; k < 2; ++k) dst[n][k] = *(const LAS bf16x8*)(lds + PG8_SB(b, h) + boff + n * 2048 + k * 1024); } } } while (0)
#define PG8_MMA(ai, bj, At, Bt) do { __builtin_amdgcn_s_setprio(1); _Pragma("unroll") for (int m = 0; m < 4; ++m) _Pragma("unroll") for (int n = 0; n < 2; ++n) { \
        if constexpr (FP8) acc[ai][bj][m][n] = __builtin_amdgcn_mfma_scale_f32_16x16x128_f8f6f4(Bt##8[n], At##8[m], acc[ai][bj][m][n], 0, 0, 0, F8_MFMA_SCALE, 0, F8_MFMA_SCALE); \
        else { _Pragma("unroll") for (int k = 0; k < 2; ++k) acc[ai][bj][m][n] = __builtin_amdgcn_mfma_f32_16x16x32_bf16(Bt[n][k], At[m][k], acc[ai][bj][m][n], 0, 0, 0); } } \
        __builtin_amdgcn_s_setprio(0); } while (0)
#define PG8_WAIT_V(n) asm volatile("s_waitcnt vmcnt(" #n ")" ::: "memory")
#define PG8_WAIT_L(n) asm volatile("s_waitcnt lgkmcnt(" #n ")" ::: "memory")
#define PG8_BAR __builtin_amdgcn_s_barrier()
#define PG8_SCHED __builtin_amdgcn_sched_barrier(0)
    Unit cur, nxt; int ui = 0;
    if (!S.next(0, cur)) return;
    bool has_next = S.next(1, nxt);
    unsigned vo[2][2], nvo[2][2];
    PG8_LOAD_VO(vo, cur);
    if (has_next) PG8_LOAD_VO(nvo, nxt); else {
#pragma unroll
        for (int h = 0; h < 2; ++h) { nvo[h][0] = vo[h][0]; nvo[h][1] = vo[h][1]; } }
    f32x4 acc[2][2][4][2];
    if constexpr (Epi::ACC_INIT) E.init(acc, cur, wr, wc, fr, fq); else {
#pragma unroll
    for (int a = 0; a < 2; ++a)
#pragma unroll
        for (int b = 0; b < 2; ++b)
#pragma unroll
            for (int m = 0; m < 4; ++m)
#pragma unroll
                for (int n = 0; n < 2; ++n) acc[a][b][m][n] = (f32x4){0.f, 0.f, 0.f, 0.f}; }
    bf16x8 At[4][2], B0[2][2], B1[2][2]; i32x8 At8[4], B08[2], B18[2];
    const char* cB = (const char*)g.Bt + ((size_t)cur.e * (size_t)g.strideE) * 2 + (size_t)cur.pn * tstep;
    PG8_STAGE(PG8_SB(0, 0), cB, voffB); PG8_STAGE(PG8_SB(0, 1), cB + hstep, voffB); PG8_STAGE_A(PG8_SA(0, 0), vo, 0, 0); PG8_STAGE_A(PG8_SA(0, 1), vo, 1, 0);
    if (wr == 1) PG8_BAR;
    PG8_WAIT_V(2); PG8_BAR;
    PG8_STAGE(PG8_SB(1, 0), cB + kstep, voffB); PG8_STAGE_A(PG8_SA(1, 0), vo, 0, kstep); PG8_STAGE(PG8_SB(1, 1), cB + hstep + kstep, voffB);
    PG8_WAIT_V(6); PG8_BAR;
    for (;;) {
        const char* nB = has_next ? (const char*)g.Bt + ((size_t)nxt.e * (size_t)g.strideE) * 2 + (size_t)nxt.pn * tstep : cB;
        for (int t = 0; t < nt; t += 2) {
            const bool last = (t == nt - 2);
            const size_t k1 = (size_t)(t + 1) * kstep, k2 = last ? 0 : (size_t)(t + 2) * kstep, k3 = k2 + kstep;
            const char* b2 = last ? nB : cB + (size_t)(t + 2) * kstep; const char* b3 = b2 + kstep;
            PG8_LDB(B0, 0, 0); PG8_LDB(B1, 0, 1); PG8_SCHED; PG8_LDA(At, 0, 0); PG8_STAGE_A(PG8_SA(1, 1), vo, 1, k1);
            if (last) {
#pragma unroll
                for (int h = 0; h < 2; ++h) { vo[h][0] = nvo[h][0]; vo[h][1] = nvo[h][1]; } }
            PG8_WAIT_V(8); PG8_WAIT_L(0); PG8_BAR; PG8_MMA(0, 0, At, B0); PG8_MMA(0, 1, At, B1); PG8_BAR; PG8_SCHED;
            PG8_LDA(At, 0, 1); PG8_STAGE(PG8_SB(0, 0), b2, voffB); PG8_STAGE(PG8_SB(0, 1), b2 + hstep, voffB); PG8_STAGE_A(PG8_SA(0, 0), vo, 0, k2);
            PG8_WAIT_V(8); PG8_WAIT_L(0); PG8_BAR; PG8_MMA(1, 0, At, B0); PG8_MMA(1, 1, At, B1); PG8_BAR; PG8_SCHED;
            PG8_LDB(B0, 1, 0); PG8_LDB(B1, 1, 1); PG8_SCHED; PG8_LDA(At, 1, 0); PG8_STAGE_A(PG8_SA(0, 1), vo, 1, k2);
            PG8_WAIT_V(8); PG8_WAIT_L(0); PG8_BAR; PG8_MMA(0, 0, At, B0); PG8_MMA(0, 1, At, B1); PG8_BAR; PG8_SCHED;
            PG8_LDA(At, 1, 1); PG8_STAGE(PG8_SB(1, 0), b3, voffB); PG8_STAGE(PG8_SB(1, 1), b3 + hstep, voffB); PG8_STAGE_A(PG8_SA(1, 0), vo, 0, k3);
            PG8_WAIT_V(8); PG8_WAIT_L(0); PG8_BAR; PG8_MMA(1, 0, At, B0); PG8_MMA(1, 1, At, B1); PG8_BAR; PG8_SCHED;
        }
        if (wr == 0) PG8_BAR;
        E(acc, cur, wr, wc, fr, fq);
        if (!has_next) break;
        if constexpr (Epi::ACC_INIT) E.init(acc, nxt, wr, wc, fr, fq); else {
#pragma unroll
        for (int a = 0; a < 2; ++a)
#pragma unroll
            for (int b = 0; b < 2; ++b)
#pragma unroll
                for (int m = 0; m < 4; ++m)
#pragma unroll
                    for (int n = 0; n < 2; ++n) acc[a][b][m][n] = (f32x4){0.f, 0.f, 0.f, 0.f}; }
        cur = nxt; cB = nB; ++ui;
        has_next = S.next(ui + 1, nxt);
        if (has_next) PG8_LOAD_VO(nvo, nxt);
        if (wr == 1) PG8_BAR;
    }
    PG8_WAIT_V(0);
    PG8_BAR;
#undef PG8_SA
#undef PG8_SB
#undef PG8_STAGE
#undef PG8_STAGE_A
#undef PG8_LOAD_VO
#undef PG8_LDA
#undef PG8_LDB
#undef PG8_MMA
#undef PG8_WAIT_V
#undef PG8_WAIT_L
#undef PG8_BAR
#undef PG8_SCHED
}
}

constexpr size_t MiB = 1u << 20;
constexpr size_t WS_CTL = 0, CTL_ZERO_BYTES = 160 * 1024;
constexpr size_t WS_WIN = 1 * MiB;
constexpr size_t WS_WOUT = 25 * MiB;
constexpr size_t WS_WPG = 33 * MiB;
constexpr size_t WS_WPP = 41 * MiB;
constexpr size_t WS_WR = 42 * MiB;
constexpr size_t WS_PB = 43 * MiB;
constexpr size_t WS_XN = 51 * MiB;
constexpr size_t WS_ZB = 115 * MiB;
constexpr size_t WS_MIXB = 307 * MiB;
constexpr size_t WS_X1 = 371 * MiB;
constexpr size_t WS_X1B = 499 * MiB;
constexpr size_t WS_X2 = 563 * MiB;
constexpr size_t WS_X2B = 691 * MiB;
constexpr size_t WS_PLEB = 755 * MiB;
constexpr size_t WS_RSTD = 819 * MiB;
constexpr size_t WS_TOK = 820 * MiB;
constexpr size_t WS_LIST = 821 * MiB;
constexpr size_t WS_HG = 827 * MiB;
constexpr size_t WS_ACT = 1024 * MiB;
constexpr size_t WS_Y = 1312 * MiB;
constexpr size_t WS_WGU = 1600 * MiB;
constexpr size_t WS_WDN = 2112 * MiB;
constexpr size_t WS_END = 2368 * MiB;
constexpr int CW_CNT = 32768, CNT_STRIDE = 64;
constexpr int CW_BAR = 1024;
constexpr int CW_SSQ = 16384;
constexpr int CW_PCNT = 36864;
static_assert(CW_SSQ + T <= CW_CNT && CW_CNT + NE * CNT_STRIDE <= CW_PCNT && (CW_PCNT + 64 * 64) * 4 <= (int)CTL_ZERO_BYTES, "CTL region");

constexpr int RING_OFF = 0, RING_BYTES = 131072;
constexpr int PH_BYTES = 147456;
constexpr int MISC_OFF = PH_BYTES;
constexpr int LDS_BYTES = 163840;
constexpr int MI_BAR = 0;
constexpr int MI_NT = 8;
constexpr int MI_TSTART = 64;
constexpr int MI_TILEE = 128;
constexpr int NWAVES = 8;

#define XB_TMO      128
#define XB_XCNT(j)  (256  + 64 * (j))
#define XB_XSUB(j)  (1280 + 64 * (j))
#define XB_XGEN(j)  (2304 + 64 * (j))
#define XB_TOP      3328
#define XB_TOPGEN   3392
#define XCD_BAR_WORDS 3456
#define XB_SPIN_CAP (1u << 18)
__device__ __forceinline__ unsigned xb_ld(unsigned* p)              { return __hip_atomic_load(p, __ATOMIC_RELAXED, __HIP_MEMORY_SCOPE_AGENT); }
__device__ __forceinline__ unsigned xb_add(unsigned* p, unsigned v) { return __hip_atomic_fetch_add(p, v, __ATOMIC_RELAXED, __HIP_MEMORY_SCOPE_AGENT); }
__device__ __forceinline__ unsigned xb_xcc_id() { return (unsigned)__builtin_amdgcn_s_getreg((3 << 11) | 20) & 0xFu; }
#define XB_SPIN(cond, bar) do { unsigned _sp = 0; while (cond) { __builtin_amdgcn_s_sleep(1); \
    if ((++_sp & 255u) == 0u) { if (xb_ld(&(bar)[XB_TMO])) break; if (_sp > XB_SPIN_CAP) { atomicAdd(&(bar)[XB_TMO], 1u); break; } } } } while (0)
struct XcdBarrier { unsigned* bar; unsigned x; volatile LAS unsigned* st; };
__device__ __forceinline__ XcdBarrier xcd_barrier_post(unsigned* bar, volatile LAS unsigned* st) {
    XcdBarrier b; b.bar = bar; b.x = xb_xcc_id(); b.st = st;
    if (threadIdx.x == 0) (void)xb_add(&bar[XB_XCNT(b.x)], 1u);
    return b;
}
__device__ __forceinline__ void xcd_barrier_complete(unsigned* bar, unsigned x, unsigned& nloc, unsigned& nx) {
    const unsigned G = gridDim.x * gridDim.y * gridDim.z;
    unsigned sum, cnt, mine, sp = 0u;
    for (;;) {
        sum = 0u; cnt = 0u; mine = 0u;
#pragma unroll
        for (unsigned j = 0; j < 16; ++j) { const unsigned c = xb_ld(&bar[XB_XCNT(j)]); sum += c; cnt += (c > 0u) ? 1u : 0u; mine = (j == x) ? c : mine; }
        if (sum == G) break;
        __builtin_amdgcn_s_sleep(1);
        if ((++sp & 255u) == 0u) { if (xb_ld(&bar[XB_TMO])) break; if (sp > XB_SPIN_CAP) { atomicAdd(&bar[XB_TMO], 1u); break; } }
    }
    nloc = mine > 0u ? mine : 1u; nx = cnt > 0u ? cnt : 1u;
}
__device__ __forceinline__ void xcd_barrier(const XcdBarrier& b) {
    asm volatile("s_waitcnt vmcnt(0)" ::: "memory");
    __syncthreads();
    if (threadIdx.x == 0) {
        unsigned* bar = b.bar;
        __builtin_amdgcn_s_waitcnt(0);
        unsigned nloc = b.st[0], nx = b.st[1];
        if (nloc == 0u) { xcd_barrier_complete(bar, b.x, nloc, nx); b.st[0] = nloc; b.st[1] = nx; }
        const unsigned old = xb_add(&bar[XB_XSUB(b.x)], 1u);
        const unsigned gen = old / nloc;
        if (old + 1u == (gen + 1u) * nloc) {
            __builtin_amdgcn_fence(__ATOMIC_RELEASE, "agent");
            asm volatile("s_waitcnt vmcnt(0)" ::: "memory");
            const unsigned og = xb_add(&bar[XB_TOP], 1u);
            const unsigned tg = og / nx;
            if (og + 1u == (tg + 1u) * nx) xb_add(&bar[XB_TOPGEN], 1u);
            else XB_SPIN(xb_ld(&bar[XB_TOPGEN]) == tg, bar);
            __builtin_amdgcn_fence(__ATOMIC_ACQUIRE, "agent");
            xb_add(&bar[XB_XGEN(b.x)], 1u);
            asm volatile("s_waitcnt vmcnt(0)" ::: "memory");
        } else {
            XB_SPIN(xb_ld(&bar[XB_XGEN(b.x)]) == gen, bar);
            __builtin_amdgcn_fence(__ATOMIC_ACQUIRE, "agent");
            asm volatile("s_waitcnt vmcnt(0)" ::: "memory");
        }
    }
    __syncthreads();
}

template <int MAP>
__device__ __forceinline__ void cvt_tile(const float* __restrict__ W, int N, int K, int k0, int n0, bf16_t* __restrict__ WT, const float* __restrict__ kscale, LAS unsigned* scr, int lane) {
    const int kp = lane >> 4, nq = lane & 15;
    f32x4 v[16];
#pragma unroll
    for (int i = 0; i < 8; ++i)
#pragma unroll
        for (int r = 0; r < 2; ++r) v[2 * i + r] = *(const f32x4*)(W + (size_t)(k0 + 8 * i + 2 * kp + r) * N + n0 + 4 * nq);
    if (kscale) {
#pragma unroll
        for (int i = 0; i < 8; ++i)
#pragma unroll
            for (int r = 0; r < 2; ++r) v[2 * i + r] = v[2 * i + r] * kscale[k0 + 8 * i + 2 * kp + r];
    }
#pragma unroll
    for (int i = 0; i < 8; ++i)
#pragma unroll
        for (int j = 0; j < 4; ++j) scr[(4 * nq + j) * 33 + 4 * i + kp] = cvt_pk_bf16(v[2 * i][j], v[2 * i + 1][j]);
    LDS_WAIT();
    const int c = lane & 7;
#pragma unroll
    for (int it = 0; it < 8; ++it) {
        const int nl = (lane >> 3) + 8 * it, n = n0 + nl;
        const LAS unsigned* s = scr + nl * 33 + 4 * c;
        u32x4 o; o.x = s[0]; o.y = s[1]; o.z = s[2]; o.w = s[3];
        int row; if (MAP == 0) row = n; else { const int j = n >> 1; row = 256 * (j >> 7) + 128 * (n & 1) + (j & 127); }
        *(u32x4*)(WT + (size_t)row * K + k0 + 8 * c) = o;
    }
    LDS_WAIT();
}

__device__ __forceinline__ void f8_tile_load(f32x4 (&v)[16], const float* __restrict__ W, int N, int k0, int n0, int lane) {
    const int kp = lane >> 4, nq = lane & 15;
#pragma unroll
    for (int i = 0; i < 4; ++i)
#pragma unroll
        for (int r = 0; r < 4; ++r) v[4 * i + r] = __builtin_nontemporal_load((const f32x4*)(W + (size_t)(k0 + 16 * i + 4 * kp + r) * N + n0 + 4 * nq));
}
template <int MAP>
__device__ __forceinline__ void f8_tile_finish(const f32x4 (&v)[16], const LAS float* ksl, float mul, int K, int k0, int n0, unsigned char* __restrict__ WT, LAS unsigned* scr, int lane) {
    const int kp = lane >> 4, nq = lane & 15;
    f32x4 ks[4];
#pragma unroll
    for (int i = 0; i < 4; ++i) { if (ksl) ks[i] = *(const LAS f32x4*)(ksl + k0 + 16 * i + 4 * kp); else ks[i] = (f32x4){mul, mul, mul, mul}; }
#pragma unroll
    for (int i = 0; i < 4; ++i)
#pragma unroll
        for (int j = 0; j < 4; ++j) scr[(4 * nq + j) * 17 + 4 * i + kp] = pack4_fp8(v[4 * i][j] * ks[i][0], v[4 * i + 1][j] * ks[i][1], v[4 * i + 2][j] * ks[i][2], v[4 * i + 3][j] * ks[i][3]);
    LDS_WAIT();
    const int c = lane & 3;
#pragma unroll
    for (int it = 0; it < 4; ++it) {
        const int nl = (lane >> 2) + 16 * it, n = n0 + nl;
        const LAS unsigned* sp = scr + nl * 17 + 4 * c;
        u32x4 o; o.x = sp[0]; o.y = sp[1]; o.z = sp[2]; o.w = sp[3];
        int row; if (MAP == 0) row = n; else { const int j = n >> 1; row = 256 * (j >> 7) + 128 * (n & 1) + (j & 127); }
        __builtin_nontemporal_store(o, (u32x4*)(WT + (size_t)row * K + k0 + 16 * c));
    }
    LDS_WAIT();
}
template <int MAP>
__device__ __forceinline__ void f8_convert_experts(const float* __restrict__ W, int ne, int K, int N, unsigned char* __restrict__ WT, const LAS float* ksl, float mul, int first, int stride, LAS unsigned* scr, int lane) {
    const int nb = N / 64, per_e = (K / 64) * nb, total = ne * per_e;
    f32x4 va[16], vb[16];
#define F8_LOAD(V, KS, IT) do { const int _e = (IT) / per_e, _q = (IT) % per_e; f8_tile_load(V, W + (size_t)_e * K * N, N, 64 * (_q / nb), 64 * (_q % nb), lane); } while (0)
#define F8_FINISH(V, KS, IT) do { const int _e = (IT) / per_e, _q = (IT) % per_e; f8_tile_finish<MAP>(V, ksl, mul, K, 64 * (_q / nb), 64 * (_q % nb), WT + (size_t)_e * K * N, scr, lane); } while (0)
    int it = first;
    if (it >= total) return;
    F8_LOAD(va, ka, it);
    for (;;) {
        const int itn = it + stride, ln = itn < total ? itn : it;
        F8_LOAD(vb, kb, ln);
        F8_FINISH(va, ka, it);
        if (itn >= total) break;
        const int itm = itn + stride, lm = itm < total ? itm : itn;
        F8_LOAD(va, ka, lm);
        F8_FINISH(vb, kb, itn);
        if (itm >= total) break;
        it = itm;
    }
#undef F8_LOAD
#undef F8_FINISH
}

struct Args { const float* in[22]; float* out; unsigned char* ws; int ph_lo, ph_hi, li, pad; };

__global__ void __launch_bounds__(NWAVES * 64, 2) mk_fwd(Args args) {
    extern __shared__ __attribute__((aligned(16))) unsigned char lds_raw[];
    LAS unsigned char* lds = (LAS unsigned char*)lds_raw;
    volatile LAS unsigned* MISC = (volatile LAS unsigned*)(lds + MISC_OFF);
    const int tid = threadIdx.x, lane = tid & 63, wave = __builtin_amdgcn_readfirstlane(tid >> 6);
    const int G = gridDim.x; const int bx = blockIdx.x; const int vcu = (G % 8 == 0) ? (bx % 8) * (G / 8) + bx / 8 : bx;
    const int gw = vcu * NWAVES + wave, NGW = G * NWAVES;
    unsigned char* ws = args.ws;
    gu32* ctl = (gu32*)(ws + WS_CTL);
    const float* x = args.in[0];
    bf16_t* WinT = (bf16_t*)(ws + WS_WIN); bf16_t* WoutT = (bf16_t*)(ws + WS_WOUT); bf16_t* WpgT = (bf16_t*)(ws + WS_WPG); bf16_t* WppT = (bf16_t*)(ws + WS_WPP);
    bf16_t* WguT = (bf16_t*)(ws + WS_WGU); bf16_t* WdnT = (bf16_t*)(ws + WS_WDN);
    bf16_t* XN = (bf16_t*)(ws + WS_XN); bf16_t* ZB = (bf16_t*)(ws + WS_ZB); bf16_t* MIXB = (bf16_t*)(ws + WS_MIXB); bf16_t* PB = (bf16_t*)(ws + WS_PB);
    bf16_t* X1H = (bf16_t*)(ws + WS_X1); bf16_t* X1L = (bf16_t*)(ws + WS_X1 + 64 * MiB); bf16_t* X1B = (bf16_t*)(ws + WS_X1B);
    for (int u = tid; u < 1024; u += NWAVES * 64) ((LAS unsigned*)(lds + MISC_OFF))[u] = 0u;
    __syncthreads();
    const int lo = args.ph_lo, hi = args.ph_hi;
    XcdBarrier bar; bar.bar = (unsigned*)(ctl + CW_BAR) + args.li * XCD_BAR_WORDS; bar.x = 0; bar.st = nullptr;
    if (hi - lo > 1) bar = xcd_barrier_post((unsigned*)(ctl + CW_BAR) + args.li * XCD_BAR_WORDS, MISC + MI_BAR);
#ifndef NGEMM_SPLIT
#define NGEMM_SPLIT 128
#endif
#ifndef GEMM_ROUNDS
#define GEMM_ROUNDS 11
#endif
#ifndef PHMASK
#define PHMASK 0xfff
#endif
#define IN(k) (((PHMASK >> (k)) & 1) && lo <= (k) && (k) < hi)
#define BOTH(k) (IN(k) && IN((k) + 1))

    constexpr int I_IN = 32 * 96, I_OUT = 32 * 32, I_PG = 32 * 32, I_PP = 4 * 32, I_GU1 = 32 * 64, I_DN1 = 32 * 32;
    constexpr int NITEMS_B = I_OUT + I_PG + I_PP + NE * I_GU1 + NE * I_DN1;
#define PROLOGUE_B(gwb, ngwb) do { \
        LAS unsigned* scr = (LAS unsigned*)(lds + RING_OFF + wave * 16384); \
        EXPERTS_B(gwb, ngwb); \
        for (int it = (gwb); it < I_OUT + I_PG + I_PP; it += (ngwb)) { int r = it; \
            if (r < I_OUT) { if (!OUT_FP8) cvt_tile<0>(args.in[10], D, D, 64 * (r / 32), 64 * (r % 32), WoutT, nullptr, scr, lane); continue; } r -= I_OUT; \
            if (r < I_PG) { if (!MOE_FP8) cvt_tile<0>(args.in[19], D, D, 64 * (r / 32), 64 * (r % 32), WpgT, args.in[18], scr, lane); continue; } r -= I_PG; \
            cvt_tile<0>(args.in[20], D, PLE, 64 * (r / 32), 64 * (r % 32), WppT, nullptr, scr, lane); } \
        for (int m = (gwb); m < T; m += (ngwb)) { const f32x4 v = *((const f32x4*)(args.in[1] + (size_t)m * PLE) + lane); u32x2 w; w.x = cvt_pk_bf16(v[0], v[1]); w.y = cvt_pk_bf16(v[2], v[3]); *((u32x2*)(PB + (size_t)m * PLE) + lane) = w; } \
        { bf16_t* wr_hi = (bf16_t*)(ws + WS_WR); bf16_t* wr_lo = wr_hi + NE * D; \
          for (int i = ((gwb) * 64 + lane); i < NE * D; i += (ngwb) * 64) { const int e = i / D, k = i % D; const float v = args.in[12][(size_t)k * NE + e] * args.in[11][k]; const unsigned short hb = f2bf(v); wr_hi[i] = hb; wr_lo[i] = f2bf(v - bf2f(hb)); } } \
    } while (0)
#if MOE_FP8
#define EXPERTS_B(gwb, ngwb) do { LAS float* sct = (LAS float*)(lds + RING_BYTES);     \
        for (int k = tid; k < D; k += NWAVES * 64) { sct[k] = args.in[11][k] * F8_WSCALE; sct[D + k] = args.in[18][k] * F8_WSCALE; } \
        __syncthreads(); \
        f8_convert_experts<1>(args.in[14], NE, D, 2 * DFF, (unsigned char*)WguT, sct, F8_WSCALE, (gwb), (ngwb), scr, lane); \
        f8_convert_experts<0>(args.in[16], NE, DFF, D, (unsigned char*)WdnT, nullptr, F8_WSCALE, (gwb), (ngwb), scr, lane); \
        f8_convert_experts<0>(args.in[19], 1, D, D, (unsigned char*)WpgT, sct + D, F8_WSCALE, (gwb), (ngwb), scr, lane); \
        if (OUT_FP8) f8_convert_experts<0>(args.in[10], 1, D, D, (unsigned char*)WoutT, nullptr, F8_WSCALE, (gwb), (ngwb), scr, lane); } while (0)
#else
#define EXPERTS_B(gwb, ngwb) do { for (int it = (gwb); it < NE * (I_GU1 + I_DN1); it += (ngwb)) { int r = it; \
            if (r < NE * I_GU1) { const int e = r / I_GU1, q = r % I_GU1; CVT_GU(e, q); continue; } r -= NE * I_GU1; \
            { const int e = r / I_DN1, q = r % I_DN1; CVT_DN(e, q); } } } while (0)
#endif
#if MOE_FP8
#define CVT_GU(e, q) cvt_tile_f8<1>(args.in[14] + (size_t)(e) * D * 2 * DFF, 2 * DFF, D, 64 * ((q) / 64), 64 * ((q) % 64), (unsigned char*)WguT + (size_t)(e) * 2 * DFF * D, args.in[11], F8_WSCALE, scr, lane)
#define CVT_DN(e, q) cvt_tile_f8<0>(args.in[16] + (size_t)(e) * DFF * D, D, DFF, 64 * ((q) / 32), 64 * ((q) % 32), (unsigned char*)WdnT + (size_t)(e) * D * DFF, nullptr, F8_WSCALE, scr, lane)
#else
#define CVT_GU(e, q) cvt_tile<1>(args.in[14] + (size_t)(e) * D * 2 * DFF, 2 * DFF, D, 64 * ((q) / 64), 64 * ((q) % 64), WguT + (size_t)(e) * 2 * DFF * D, args.in[11], scr, lane)
#define CVT_DN(e, q) cvt_tile<0>(args.in[16] + (size_t)(e) * DFF * D, D, DFF, 64 * ((q) / 32), 64 * ((q) % 32), WdnT + (size_t)(e) * D * DFF, nullptr, scr, lane)
#endif
    const int NGEMM = (G == 256) ? NGEMM_SPLIT : G;
    if (IN(0)) {
        LAS unsigned* scr = (LAS unsigned*)(lds + RING_OFF + wave * 16384);
        for (int it = gw; it < I_IN; it += NGW) cvt_tile<0>(args.in[3], IN_W, D, 64 * (it / 96), 64 * (it % 96), WinT, nullptr, scr, lane);
        for (int m = gw; m < T; m += NGW) {
            const f32x4* xr = (const f32x4*)(x + (size_t)m * D) + lane; const f32x4* gr = (const f32x4*)args.in[2] + lane;
            f32x4 v[8]; float s = 0.f;
#pragma unroll
            for (int j = 0; j < 8; ++j) { v[j] = xr[64 * j]; s += (v[j][0] * v[j][0] + v[j][1] * v[j][1]) + (v[j][2] * v[j][2] + v[j][3] * v[j][3]); }
            const float rr = rsqrtf(wave_sum(s) * (1.f / D) + RMS_EPS);
            u32x2* o8 = (u32x2*)(XN + (size_t)m * D) + lane;
#pragma unroll
            for (int j = 0; j < 8; ++j) { const f32x4 gg = gr[64 * j]; u32x2 w; w.x = cvt_pk_bf16(v[j][0] * rr * gg[0], v[j][1] * rr * gg[1]); w.y = cvt_pk_bf16(v[j][2] * rr * gg[2], v[j][3] * rr * gg[3]); o8[64 * j] = w; }
        }
        if (!IN(1) || NGEMM == G) PROLOGUE_B(gw, NGW);
        if (BOTH(0)) xcd_barrier(bar);
    }
    if (IN(1)) {
        const bool split = (NGEMM != G) && IN(0);
        if (split && bx >= NGEMM) { PROLOGUE_B((bx - NGEMM) * NWAVES + wave, (G - NGEMM) * NWAVES); __syncthreads(); }
        {
            pg8::Gemm g{XN, WinT, nullptr, 0, D, 0}; pg8::StaticOrder S;
            if (!split) S.init(T, IN_W, G, bx); else if (bx < NGEMM) S.init(T, IN_W, NGEMM, bx, 0, GEMM_ROUNDS); else S.init(T, IN_W, G - NGEMM, bx - NGEMM, GEMM_ROUNDS * NGEMM / (G - NGEMM));
            pg8::EpiBf16 E{ZB, IN_W};
            pg8::gemm_phase<pg8::EpiBf16, pg8::StaticOrder, false>(lds + RING_OFF, g, S, E);
        }
        if (BOTH(1)) xcd_barrier(bar);
    }

    if (IN(2)) {
        LAS unsigned char* STb = lds;
        LAS unsigned char* QBl = lds + 34816;
        LAS unsigned char* QRl = lds + 52224;
        LAS unsigned char* KBl = lds + 69632;
        LAS unsigned char* KBLT = lds + 87040;
        LAS unsigned char* VT = lds + 105472;
        LAS unsigned char* PL = lds + 123904;
        LAS float* tot = (LAS float*)(lds + 133120);
        LAS float* dec = (LAS float*)(lds + 135168);
        bf16_t* OL = (bf16_t*)(ws + WS_HG)  ; bf16_t* QBF = (bf16_t*)(ws + WS_HG + 64 * MiB); float* SL = (float*)(ws + WS_HG + 96 * MiB); float* DL = (float*)(ws + WS_HG + 128 * MiB);
        const int d = tid & 127, q = tid >> 7, fr = lane & 15, fq = lane >> 4, tm = wave >> 1, eh = wave & 1;
        for (int unit = bx; unit < BATCH * HG_H * 16; unit += G) {
            const int bh = unit >> 4, sc = unit & 15, b = bh >> 3, h = bh & 7, t_base = b * SEQ + sc * 256;
            const float l0 = args.in[4][h * 128 + d], l1 = args.in[4][HG_K + h * 128 + d]; const float lbv = 1.f / (1.f + expf(l1 - l0));
            f32x4 sacc[8];
#pragma unroll
            for (int i = 0; i < 8; ++i) sacc[i] = (f32x4){0.f, 0.f, 0.f, 0.f};
            float Bcum = 0.f;
            const int rw0 = tid >> 4, rch = tid & 15;
            LAS unsigned char* RAWQ = lds + 34816; LAS unsigned char* RAWF = lds + 51200; LAS unsigned char* RAWV = lds + 67584;
            u32x4 pq[2], pf[2], pv[2];
#pragma unroll
            for (int i = 0; i < 2; ++i) { const bf16_t* zr = ZB + (size_t)(t_base + rw0 + 32 * i) * IN_W + h * 128 + rch * 8; pq[i] = *(const u32x4*)(zr + ZQ); pf[i] = *(const u32x4*)(zr + ZF); pv[i] = *(const u32x4*)(zr + ZI); }
            for (int c = 0; c < 4; ++c) {
                const int tc = t_base + 64 * c;
#pragma unroll
                for (int i = 0; i < 2; ++i) { *(LAS u32x4*)(RAWQ + (rw0 + 32 * i) * 256 + rch * 16) = pq[i]; *(LAS u32x4*)(RAWF + (rw0 + 32 * i) * 256 + rch * 16) = pf[i]; *(LAS u32x4*)(RAWV + (rw0 + 32 * i) * 256 + rch * 16) = pv[i]; }
                __syncthreads();
                unsigned short qr[16], fr_[16], vr[16];
#pragma unroll
                for (int i = 0; i < 16; ++i) { qr[i] = *(const LAS unsigned short*)(RAWQ + (16 * q + i) * 256 + d * 2); fr_[i] = *(const LAS unsigned short*)(RAWF + (16 * q + i) * 256 + d * 2); vr[i] = *(const LAS unsigned short*)(RAWV + (16 * q + i) * 256 + d * 2); }
                float bl[16], qs[16], kk[16]; float run = 0.f;
#pragma unroll
                for (int i = 0; i < 16; ++i) { const float qf = bf2f(qr[i]); qs[i] = qf * fast_sigmoid(qf); const float f = lbv + (1.f - lbv) * fast_sigmoid(bf2f(fr_[i])); kk[i] = 1.f - f; run += fast_log(f); bl[i] = run; }
                tot[q * 128 + d] = run;
                __syncthreads();
                const float t0 = tot[d], t1 = tot[128 + d], t2 = tot[256 + d], t3 = tot[384 + d];
                const float off = (q > 0 ? t0 : 0.f) + (q > 1 ? t1 : 0.f) + (q > 2 ? t2 : 0.f), blast = (t0 + t1) + (t2 + t3), R = 0.5f * blast;
                unsigned kw[8], vw[8];
#pragma unroll
                for (int i = 0; i < 16; i += 2) {
                    float kb2[2];
#pragma unroll
                    for (int j = 0; j < 2; ++j) { const float bb = bl[i + j] + off; const int tt = 16 * q + i + j;
                        const float eb = fast_exp(bb), qbv = qs[i + j] * eb;
                        *(LAS unsigned short*)(QBl + tt * 272 + d * 2) = f2bf(qbv);
                        *(LAS unsigned short*)(QRl + tt * 272 + d * 2) = f2bf(qs[i + j] * fast_exp(bb - R));
                        *(LAS unsigned short*)(KBl + tt * 272 + d * 2) = f2bf(kk[i + j] * fast_exp(R - bb));
                        QBF[(size_t)(tc + tt) * HG_K + h * 128 + d] = f2bf(qs[i + j] * fast_exp(Bcum + bb));
                        kb2[j] = kk[i + j] * fast_exp(blast - bb); }
                    kw[i >> 1] = cvt_pk_bf16(kb2[0], kb2[1]); vw[i >> 1] = (unsigned)vr[i] | ((unsigned)vr[i + 1] << 16);
                }
                *(LAS u32x4*)(KBLT + d * 144 + q * 32) = (u32x4){kw[0], kw[1], kw[2], kw[3]}; *(LAS u32x4*)(KBLT + d * 144 + q * 32 + 16) = (u32x4){kw[4], kw[5], kw[6], kw[7]};
                *(LAS u32x4*)(VT + d * 144 + q * 32) = (u32x4){vw[0], vw[1], vw[2], vw[3]}; *(LAS u32x4*)(VT + d * 144 + q * 32 + 16) = (u32x4){vw[4], vw[5], vw[6], vw[7]};
                if (q == 0) dec[d] = fast_exp(blast);
                Bcum += blast;
                if (c < 3) {
#pragma unroll
                    for (int i = 0; i < 2; ++i) { const bf16_t* zr = ZB + (size_t)(tc + 64 + rw0 + 32 * i) * IN_W + h * 128 + rch * 8; pq[i] = *(const u32x4*)(zr + ZQ); pf[i] = *(const u32x4*)(zr + ZF); pv[i] = *(const u32x4*)(zr + ZI); } }
                __syncthreads();
#pragma unroll
                for (int si = 0; si < 2; ++si) { const int ts = 2 * eh + si; u32x2 pw = (u32x2){0u, 0u};
                    if (ts <= tm) { f32x4 a4 = (f32x4){0.f, 0.f, 0.f, 0.f};
#pragma unroll
                        for (int ks = 0; ks < 4; ++ks) { const bf16x8 af = *(const LAS bf16x8*)(KBl + (ts * 16 + fr) * 272 + (32 * ks + 8 * fq) * 2), bfv = *(const LAS bf16x8*)(QRl + (tm * 16 + fr) * 272 + (32 * ks + 8 * fq) * 2);
                            a4 = __builtin_amdgcn_mfma_f32_16x16x32_bf16(af, bfv, a4, 0, 0, 0); }
                        const int tt = tm * 16 + fr, s0 = ts * 16 + 4 * fq;
                        pw.x = cvt_pk_bf16(s0 + 0 <= tt ? a4[0] : 0.f, s0 + 1 <= tt ? a4[1] : 0.f); pw.y = cvt_pk_bf16(s0 + 2 <= tt ? a4[2] : 0.f, s0 + 3 <= tt ? a4[3] : 0.f); }
                    *(LAS u32x2*)(PL + (tm * 16 + fr) * 144 + (ts * 16 + 4 * fq) * 2) = pw; }
                f32x4 oacc[4];
#pragma unroll
                for (int et = 0; et < 4; ++et) oacc[et] = (f32x4){0.f, 0.f, 0.f, 0.f};
                if (c > 0) {
#pragma unroll
                    for (int ks = 0; ks < 4; ++ks) { const bf16x8 bfv = *(const LAS bf16x8*)(QBl + (tm * 16 + fr) * 272 + (32 * ks + 8 * fq) * 2);
#pragma unroll
                        for (int et = 0; et < 4; ++et) { const bf16x8 af = *(const LAS bf16x8*)(STb + ((4 * eh + et) * 16 + fr) * 272 + (32 * ks + 8 * fq) * 2);
                            oacc[et] = __builtin_amdgcn_mfma_f32_16x16x32_bf16(af, bfv, oacc[et], 0, 0, 0); } }
                }
                __syncthreads();
#pragma unroll
                for (int ks = 0; ks < 2; ++ks) if (32 * ks <= 16 * tm + 15) { const bf16x8 bfv = *(const LAS bf16x8*)(PL + (tm * 16 + fr) * 144 + (32 * ks + 8 * fq) * 2);
#pragma unroll
                    for (int et = 0; et < 4; ++et) { const bf16x8 af = *(const LAS bf16x8*)(VT + ((4 * eh + et) * 16 + fr) * 144 + (32 * ks + 8 * fq) * 2);
                        oacc[et] = __builtin_amdgcn_mfma_f32_16x16x32_bf16(af, bfv, oacc[et], 0, 0, 0); } }
#pragma unroll
                for (int et = 0; et < 4; ++et) { u32x2 w; w.x = cvt_pk_bf16(oacc[et][0], oacc[et][1]); w.y = cvt_pk_bf16(oacc[et][2], oacc[et][3]); *(u32x2*)(OL + (size_t)(tc + tm * 16 + fr) * HG_V + h * 128 + (4 * eh + et) * 16 + 4 * fq) = w; }
#pragma unroll
                for (int dt = 0; dt < 8; ++dt) { const f32x4 dv = *(const LAS f32x4*)(dec + 16 * dt + 4 * fq); sacc[dt] = sacc[dt] * dv;
#pragma unroll
                    for (int ks = 0; ks < 2; ++ks) { const bf16x8 af = *(const LAS bf16x8*)(KBLT + (dt * 16 + fr) * 144 + (32 * ks + 8 * fq) * 2), bfv = *(const LAS bf16x8*)(VT + (wave * 16 + fr) * 144 + (32 * ks + 8 * fq) * 2);
                        sacc[dt] = __builtin_amdgcn_mfma_f32_16x16x32_bf16(af, bfv, sacc[dt], 0, 0, 0); }
                    if (c < 3) { u32x2 w; w.x = cvt_pk_bf16(sacc[dt][0], sacc[dt][1]); w.y = cvt_pk_bf16(sacc[dt][2], sacc[dt][3]); *(LAS u32x2*)(STb + (wave * 16 + fr) * 272 + (16 * dt + 4 * fq) * 2) = w; } }
            }
#pragma unroll
            for (int dt = 0; dt < 8; ++dt) *(f32x4*)(SL + (size_t)unit * 16384 + (wave * 16 + fr) * 128 + 16 * dt + 4 * fq) = sacc[dt];
            if (q == 0) DL[unit * 128 + d] = fast_exp(Bcum);
            __syncthreads();
        }
        { float* stats = (float*)(ws + WS_HG + 145 * MiB);
          for (int t = gw; t < T; t += NGW) {
            const u32x4 w0 = *(const u32x4*)(ZB + (size_t)t * IN_W + ZV + 16 * lane), w1 = *(const u32x4*)(ZB + (size_t)t * IN_W + ZV + 16 * lane + 8);
            float v[16] = {bflo(w0.x), bfhi(w0.x), bflo(w0.y), bfhi(w0.y), bflo(w0.z), bfhi(w0.z), bflo(w0.w), bfhi(w0.w), bflo(w1.x), bfhi(w1.x), bflo(w1.y), bfhi(w1.y), bflo(w1.z), bfhi(w1.z), bflo(w1.w), bfhi(w1.w)};
            float sm = 0.f;
#pragma unroll
            for (int j = 0; j < 16; ++j) { v[j] = gelu_fast(v[j]); sm += v[j]; }
            const float mu = wave_sum(sm) * (1.f / GM_W); float qq = 0.f;
#pragma unroll
            for (int j = 0; j < 16; ++j) { const float dd = v[j] - mu; qq += dd * dd; }
            const float rs = rsqrtf(wave_sum(qq) * (1.f / GM_W) + LN_EPS);
            if (lane == 0) { stats[2 * t] = mu; stats[2 * t + 1] = rs; } } }
        if (BOTH(2)) xcd_barrier(bar);
    }
    if (IN(3)) {
        const float* SL = (const float*)(ws + WS_HG + 96 * MiB); const float* DL = (const float*)(ws + WS_HG + 128 * MiB); bf16_t* SINb = (bf16_t*)(ws + WS_HG + 129 * MiB);
        for (int item = bx; item < BATCH * HG_H * 8; item += G) {
            const int bh = item >> 3, sl = item & 7; const int eo = sl * 2048 + tid * 4;
            f32x4 st = (f32x4){0.f, 0.f, 0.f, 0.f};
#pragma unroll
            for (int sc = 0; sc < 15; ++sc) { const int unit = bh * 16 + sc;
                const f32x4 sl4 = *(const f32x4*)(SL + (size_t)unit * 16384 + eo), dv = *(const f32x4*)(DL + unit * 128 + (eo & 127));
                st = st * dv + sl4;
                u32x2 w; w.x = cvt_pk_bf16(st[0], st[1]); w.y = cvt_pk_bf16(st[2], st[3]); *(u32x2*)(SINb + (size_t)(unit + 1) * 16384 + eo) = w; }
        }
        if (BOTH(3)) xcd_barrier(bar);
    }
    if (IN(4)) {
        const bf16_t* OL = (const bf16_t*)(ws + WS_HG); const bf16_t* QBF = (const bf16_t*)(ws + WS_HG + 64 * MiB); const bf16_t* SINb = (const bf16_t*)(ws + WS_HG + 129 * MiB);
        const int fr = lane & 15, fq = lane >> 4;
        for (int unit = bx; unit < BATCH * HG_H * 32; unit += G) {
            const int bh = unit >> 5, blk = unit & 31, b = bh >> 3, h = bh & 7, sc = blk >> 1;
            const int t = b * SEQ + blk * 128 + wave * 16 + fr;
            f32x4 acc[8]; u32x2 ogv[8];
#pragma unroll
            for (int et = 0; et < 8; ++et) { const u32x2 ow = *(const u32x2*)(OL + (size_t)t * HG_V + h * 128 + et * 16 + 4 * fq); acc[et] = (f32x4){bflo(ow.x), bfhi(ow.x), bflo(ow.y), bfhi(ow.y)}; ogv[et] = *(const u32x2*)(ZB + (size_t)t * IN_W + ZG + h * 128 + et * 16 + 4 * fq); }
            if (sc > 0) { const bf16_t* Sp = SINb + (size_t)(bh * 16 + sc) * 16384;
#pragma unroll
                for (int ks = 0; ks < 4; ++ks) { const bf16x8 bfv = *(const bf16x8*)(QBF + (size_t)t * HG_K + h * 128 + 32 * ks + 8 * fq);
#pragma unroll
                    for (int et = 0; et < 8; ++et) { const bf16x8 af = *(const bf16x8*)(Sp + (et * 16 + fr) * 128 + 32 * ks + 8 * fq);
                        acc[et] = __builtin_amdgcn_mfma_f32_16x16x32_bf16(af, bfv, acc[et], 0, 0, 0); } } }
            float ss = 0.f;
#pragma unroll
            for (int et = 0; et < 8; ++et) ss += (acc[et][0] * acc[et][0] + acc[et][1] * acc[et][1]) + (acc[et][2] * acc[et][2] + acc[et][3] * acc[et][3]);
            ss += __shfl_xor(ss, 16); ss += __shfl_xor(ss, 32);
            const float rr = rsqrtf(ss * (1.f / 128.f) + RMS_EPS);
#pragma unroll
            for (int et = 0; et < 8; ++et) { const int e0 = h * 128 + et * 16 + 4 * fq;
                const f32x4 gn = *(const f32x4*)(args.in[5] + e0); const u32x2 og = ogv[et];
                const float m0 = acc[et][0] * rr * gn[0] * fast_sigmoid(bflo(og.x)), m1 = acc[et][1] * rr * gn[1] * fast_sigmoid(bfhi(og.x)), m2 = acc[et][2] * rr * gn[2] * fast_sigmoid(bflo(og.y)), m3 = acc[et][3] * rr * gn[3] * fast_sigmoid(bfhi(og.y));
#if OUT_FP8
                *(unsigned*)((unsigned char*)MIXB + (size_t)t * D + e0) = pack4_fp8c(m0 * F8_MSCALE, m1 * F8_MSCALE, m2 * F8_MSCALE, m3 * F8_MSCALE); }
#else
                u32x2 w; w.x = cvt_pk_bf16(m0, m1); w.y = cvt_pk_bf16(m2, m3);
                *(u32x2*)(MIXB + (size_t)t * D + e0) = w; }
#endif
        }
        {
            LAS unsigned char* VNT = lds;
            LAS unsigned char* WL = lds + 34816;
            const float* stats = (const float*)(ws + WS_HG + 145 * MiB);
            __syncthreads();
            for (int unit = bx; unit < BATCH * 32 * GM_G; unit += G) {
                const int g = unit & 7, tb = (unit >> 3) * 128;
                LAS float* sst = (LAS float*)(lds + 69632);
                const int c8 = tid & 15, sr = tid >> 4, tw = tid >> 2, seg = tid & 3;
                u32x4 vraw[4];
#pragma unroll
                for (int i = 0; i < 4; ++i) vraw[i] = *(const u32x4*)(ZB + (size_t)(tb + 4 * sr + i) * IN_W + ZV + g * 128 + 8 * c8);
                f32x4 w4[8]; { const float* wp = args.in[8] + ((size_t)g * 128 + tw) * 128 + 32 * seg;
#pragma unroll
                  for (int j = 0; j < 8; ++j) w4[j] = *(const f32x4*)(wp + 4 * j); }
                u32x2 uw[8];
#pragma unroll
                for (int ct = 0; ct < 8; ++ct) uw[ct] = *(const u32x2*)(ZB + (size_t)(tb + 16 * wave + fr) * IN_W + ZU + g * 128 + 16 * ct + 4 * fq);
                const f32x4 lg0 = *(const f32x4*)(args.in[6] + g * 128 + 8 * c8), lg1 = *(const f32x4*)(args.in[6] + g * 128 + 8 * c8 + 4), lb0 = *(const f32x4*)(args.in[7] + g * 128 + 8 * c8), lb1 = *(const f32x4*)(args.in[7] + g * 128 + 8 * c8 + 4);
                if (tid < 256) sst[tid] = ld_agent_f(stats + 2 * tb + tid);
                __syncthreads();
                { const float lgv[8] = {lg0[0], lg0[1], lg0[2], lg0[3], lg1[0], lg1[1], lg1[2], lg1[3]}, lbv8[8] = {lb0[0], lb0[1], lb0[2], lb0[3], lb1[0], lb1[1], lb1[2], lb1[3]};
                  float vn4[4][8];
#pragma unroll
                  for (int i = 0; i < 4; ++i) { const f32x2 st = *(const LAS f32x2*)(sst + 2 * (4 * sr + i)); const u32x4 w = vraw[i];
                      const float rv[8] = {bflo(w.x), bfhi(w.x), bflo(w.y), bfhi(w.y), bflo(w.z), bfhi(w.z), bflo(w.w), bfhi(w.w)};
#pragma unroll
                      for (int j = 0; j < 8; ++j) vn4[i][j] = (gelu_fast(rv[j]) - st[0]) * st[1] * lgv[j] + lbv8[j]; }
#pragma unroll
                  for (int j = 0; j < 8; ++j) { u32x2 w; w.x = cvt_pk_bf16(vn4[0][j], vn4[1][j]); w.y = cvt_pk_bf16(vn4[2][j], vn4[3][j]); *(LAS u32x2*)(VNT + (8 * c8 + j) * 272 + 8 * sr) = w; } }
                { unsigned pk[16];
#pragma unroll
                  for (int j = 0; j < 8; ++j) { const int s0 = 32 * seg + 4 * j;
                      pk[2 * j] = cvt_pk_bf16(s0 <= tw ? w4[j][0] : 0.f, s0 + 1 <= tw ? w4[j][1] : 0.f); pk[2 * j + 1] = cvt_pk_bf16(s0 + 2 <= tw ? w4[j][2] : 0.f, s0 + 3 <= tw ? w4[j][3] : 0.f); }
#pragma unroll
                  for (int j = 0; j < 4; ++j) *(LAS u32x4*)(WL + tw * 272 + seg * 64 + j * 16) = (u32x4){pk[4 * j], pk[4 * j + 1], pk[4 * j + 2], pk[4 * j + 3]}; }
                __syncthreads();
                f32x4 acc[8];
#pragma unroll
                for (int ct = 0; ct < 8; ++ct) acc[ct] = (f32x4){0.f, 0.f, 0.f, 0.f};
                for (int ks = 0; ks <= (16 * wave + 15) >> 5; ++ks) { const bf16x8 bfv = *(const LAS bf16x8*)(WL + (16 * wave + fr) * 272 + (32 * ks + 8 * fq) * 2);
#pragma unroll
                    for (int ct = 0; ct < 8; ++ct) { const bf16x8 af = *(const LAS bf16x8*)(VNT + (16 * ct + fr) * 272 + (32 * ks + 8 * fq) * 2);
                        acc[ct] = __builtin_amdgcn_mfma_f32_16x16x32_bf16(af, bfv, acc[ct], 0, 0, 0); } }
                const int t = tb + 16 * wave + fr; const float bsv = args.in[9][g * 128 + 16 * wave + fr];
#pragma unroll
                for (int ct = 0; ct < 8; ++ct) { const int c0 = g * 128 + 16 * ct + 4 * fq;
                    const float m0 = gelu_fast(bflo(uw[ct].x)) * (acc[ct][0] + bsv), m1 = gelu_fast(bfhi(uw[ct].x)) * (acc[ct][1] + bsv), m2 = gelu_fast(bflo(uw[ct].y)) * (acc[ct][2] + bsv), m3 = gelu_fast(bfhi(uw[ct].y)) * (acc[ct][3] + bsv);
#if OUT_FP8
                    *(unsigned*)((unsigned char*)MIXB + (size_t)t * D + 1024 + c0) = pack4_fp8c(m0 * F8_MSCALE, m1 * F8_MSCALE, m2 * F8_MSCALE, m3 * F8_MSCALE); }
#else
                    u32x2 w; w.x = cvt_pk_bf16(m0, m1); w.y = cvt_pk_bf16(m2, m3);
                    *(u32x2*)(MIXB + (size_t)t * D + 1024 + c0) = w; }
#endif
                __syncthreads();
            }
        }
        if (BOTH(4)) xcd_barrier(bar);
    }
    if (IN(5)) {
        pg8::Gemm g{MIXB, WoutT, nullptr, 0, D / (OUT_FP8 ? 2 : 1), 0}; pg8::StaticOrder S; S.init(T, D, G, bx);
        pg8::EpiResF32Bf16 E{x, X1H, X1L, X1B};
        pg8::gemm_phase<pg8::EpiResF32Bf16, pg8::StaticOrder, false, OUT_FP8 != 0>(lds + RING_OFF, g, S, E);
        if (BOTH(5)) xcd_barrier(bar);
    }

    if (IN(6)) {
        typedef float f32x16 __attribute__((ext_vector_type(16)));
        const bf16_t* wr_hi = (const bf16_t*)(ws + WS_WR); const bf16_t* wr_lo = wr_hi + NE * D;
        int* cntg = (int*)(ctl + CW_CNT);
        int* list = (int*)(ws + WS_LIST); float* rsl = (float*)(ws + WS_LIST + 2 * MiB); float* gtl = (float*)(ws + WS_LIST + 4 * MiB);
        int* tok_e = (int*)(ws + WS_TOK); int* tok_p = tok_e + T * 4; float* tok_g = (float*)(tok_p + T * 4);
        LAS float* part = (LAS float*)(lds + RING_OFF);
        LAS float* ssqp = (LAS float*)(lds + RING_OFF + 36864);
        LAS float* lgt = (LAS float*)(lds + RING_OFF + 40960);
        LAS int* hist = (LAS int*)(lds + RING_OFF + 53248);
        const int tg = wave >> 2, kq = wave & 3, r = lane & 31, h = lane >> 5;
        for (int grp = bx; grp < T / 64; grp += G) {
            const int t0 = grp * 64;
            if (tid < 64) hist[tid] = 0;
            f32x16 acc;
#pragma unroll
            for (int i = 0; i < 16; ++i) acc[i] = 0.f;
            const bf16_t* xhp = X1H + (size_t)(t0 + tg * 32 + r) * D + kq * 512 + 8 * h; const bf16_t* xlp = X1L + (size_t)(t0 + tg * 32 + r) * D + kq * 512 + 8 * h;
            const bf16_t* whp = wr_hi + (size_t)r * D + kq * 512 + 8 * h; const bf16_t* wlp = wr_lo + (size_t)r * D + kq * 512 + 8 * h;
            float ss = 0.f;
#pragma unroll 8
            for (int s = 0; s < 32; ++s) {
                const bf16x8 xh = *(const bf16x8*)(xhp + 16 * s); bf16x8 xl = xh; if (X1_LO) xl = *(const bf16x8*)(xlp + 16 * s);
                const bf16x8 wh = *(const bf16x8*)(whp + 16 * s), wl = *(const bf16x8*)(wlp + 16 * s);
#pragma unroll
                for (int j = 0; j < 8; ++j) { const float xv = bf2f((unsigned short)xh[j]) + (X1_LO ? bf2f((unsigned short)xl[j]) : 0.f); ss += xv * xv; }
                acc = __builtin_amdgcn_mfma_f32_32x32x16_bf16(wh, xh, acc, 0, 0, 0);
                if (X1_LO) acc = __builtin_amdgcn_mfma_f32_32x32x16_bf16(wh, xl, acc, 0, 0, 0);
                acc = __builtin_amdgcn_mfma_f32_32x32x16_bf16(wl, xh, acc, 0, 0, 0);
            }
            ss += __shfl_xor(ss, 32);
            if (h == 0) ssqp[(tg * 4 + kq) * 32 + r] = ss;
#pragma unroll
            for (int i = 0; i < 16; ++i) part[((tg * 4 + kq) * 32 + r) * 33 + (i & 3) + 8 * (i >> 2) + 4 * h] = acc[i];
            __syncthreads();
            {
                const int tk = lane, tgg = tk >> 5, rr = tk & 31;
                const float sq = ssqp[(tgg * 4 + 0) * 32 + rr] + ssqp[(tgg * 4 + 1) * 32 + rr] + ssqp[(tgg * 4 + 2) * 32 + rr] + ssqp[(tgg * 4 + 3) * 32 + rr];
                const float rstd = rsqrtf(sq * (1.f / D) + RMS_EPS);
#pragma unroll
                for (int j = 0; j < 4; ++j) { const int e = wave * 4 + j;
                    const float v = part[((tgg * 4 + 0) * 32 + rr) * 33 + e] + part[((tgg * 4 + 1) * 32 + rr) * 33 + e] + part[((tgg * 4 + 2) * 32 + rr) * 33 + e] + part[((tgg * 4 + 3) * 32 + rr) * 33 + e];
                    lgt[tk * 33 + e] = v * rstd + args.in[13][e]; }
                if (wave == 0) lgt[tk * 33 + 32] = rstd;
            }
            __syncthreads();
            if (wave == 0) {
                const int t = t0 + lane;
                float lv[32];
#pragma unroll
                for (int e = 0; e < 32; ++e) lv[e] = lgt[lane * 33 + e];
                const float rstd = lgt[lane * 33 + 32];
                float tv[4]; int ti[4];
#pragma unroll
                for (int k = 0; k < 4; ++k) { float bv = lv[0]; int bi = 0;
#pragma unroll
                    for (int e = 1; e < 32; ++e) if (lv[e] > bv) { bv = lv[e]; bi = e; }
                    tv[k] = bv; ti[k] = bi;
#pragma unroll
                    for (int e = 0; e < 32; ++e) if (e == bi) lv[e] = -INFINITY; }
                const float e1 = expf(tv[1] - tv[0]), e2 = expf(tv[2] - tv[0]), e3 = expf(tv[3] - tv[0]); const float inv = 1.f / (1.f + e1 + e2 + e3);
                const float gk[4] = {inv, e1 * inv, e2 * inv, e3 * inv};
                int rk[4];
#pragma unroll
                for (int k = 0; k < 4; ++k) rk[k] = __hip_atomic_fetch_add(hist + ti[k], 1, __ATOMIC_RELAXED, __HIP_MEMORY_SCOPE_WORKGROUP);
                LDS_WAIT();
                if (lane < 32) { const int c = hist[lane]; hist[32 + lane] = c > 0 ? atomicAdd(cntg + lane * CNT_STRIDE, c) : 0; }
                LDS_WAIT();
#pragma unroll
                for (int k = 0; k < 4; ++k) { const int e = ti[k], ps = hist[32 + e] + rk[k];
                    list[e * LISTCAP + ps] = t; rsl[e * LISTCAP + ps] = rstd; gtl[e * LISTCAP + ps] = gk[k];
                    tok_e[t * 4 + k] = e; tok_p[t * 4 + k] = ps; tok_g[t * 4 + k] = gk[k]; }
            }
            __syncthreads();
        }
        if (BOTH(6)) xcd_barrier(bar);
    }
#define BUILD_TILE_TABLE() do { \
        if (wave == 0) { const int c = lane < NE ? ((const int*)(ctl + CW_CNT))[lane * CNT_STRIDE] : 0; int nt = (c + 255) >> 8, inc = nt; \
            _Pragma("unroll") for (int o = 1; o < 64; o <<= 1) { const int v = __shfl_up(inc, o); if (lane >= o) inc += v; } \
            if (lane < NE) MISC[MI_TSTART + lane] = (unsigned)(inc - nt); if (lane == NE - 1) { MISC[MI_TSTART + NE] = (unsigned)inc; MISC[MI_NT] = (unsigned)inc; } } \
        __syncthreads(); \
        { const int NTt = (int)MISC[MI_NT]; if (tid < NTt) { int e = 0; _Pragma("unroll") for (int q = 1; q < NE; ++q) e += ((int)MISC[MI_TSTART + q] <= tid) ? 1 : 0; MISC[MI_TILEE + tid] = (unsigned)e; } } \
        __syncthreads(); } while (0)
    if (IN(7)) {
        BUILD_TILE_TABLE();
        pg8::Gemm g{X1B, WguT, (const int*)(ws + WS_LIST), (long long)2 * DFF * D / (MOE_FP8 ? 2 : 1), D / (MOE_FP8 ? 2 : 1), T - 1};
        pg8::MoeOrder S{(int)MISC[MI_NT], 2 * DFF / 256, G, bx, (const LAS int*)(lds + MISC_OFF) + MI_TILEE, (const LAS int*)(lds + MISC_OFF) + MI_TSTART};
        pg8::EpiSwiglu E{(bf16_t*)(ws + WS_ACT), (const float*)(ws + WS_LIST + 2 * MiB), args.in[15]};
        pg8::gemm_phase<pg8::EpiSwiglu, pg8::MoeOrder, true, MOE_FP8 != 0>(lds + RING_OFF, g, S, E);
        if (BOTH(7)) xcd_barrier(bar);
    }
    if (IN(8)) {
        BUILD_TILE_TABLE();
        pg8::Gemm g{(const bf16_t*)(ws + WS_ACT), WdnT, nullptr, (long long)D * DFF / (MOE_FP8 ? 2 : 1), DFF / (MOE_FP8 ? 2 : 1), 0};
        pg8::MoeOrder S{(int)MISC[MI_NT], D / 256, G, bx, (const LAS int*)(lds + MISC_OFF) + MI_TILEE, (const LAS int*)(lds + MISC_OFF) + MI_TSTART};
        pg8::EpiDown E{(bf16_t*)(ws + WS_Y), (const float*)(ws + WS_LIST + 4 * MiB), args.in[17]};
        pg8::gemm_phase<pg8::EpiDown, pg8::MoeOrder, false, MOE_FP8 != 0>(lds + RING_OFF, g, S, E);
        if (BOTH(8)) xcd_barrier(bar);
    }
    if (IN(9)) {
        BUILD_TILE_TABLE();
        const int* tok_e = (const int*)(ws + WS_TOK); const int* tok_p = tok_e + T * 4;
        bf16_t* X2B = (bf16_t*)(ws + WS_X2B); unsigned char* X2F8 = (unsigned char*)(ws + WS_X2); float* rstd2 = (float*)(ws + WS_RSTD);
        for (int tb0 = gw; tb0 < T; tb0 += 8 * NGW) {
          int myrow = 0; { const int tt = tb0 + (lane >> 2) * NGW; if (lane < 32 && tt < T) { const int e = tok_e[tt * 4 + (lane & 3)]; myrow = (int)MISC[MI_TSTART + e] * 256 + tok_p[tt * 4 + (lane & 3)]; } }
#pragma unroll 2
          for (int ti = 0; ti < 8; ++ti) { const int t = tb0 + ti * NGW; if (t >= T) break;
            int rowk[4];
#pragma unroll
            for (int k = 0; k < 4; ++k) rowk[k] = __shfl(myrow, ti * 4 + k);
            float s = 0.f;
#pragma unroll
            for (int j = 0; j < 4; ++j) {
                const size_t c = (size_t)8 * lane + 512 * j;
                const u32x4 ah = __builtin_nontemporal_load((const u32x4*)(X1H + (size_t)t * D + c)); u32x4 al = (u32x4){0u, 0u, 0u, 0u}; if (X1_LO) al = *(const u32x4*)(X1L + (size_t)t * D + c);
                float v[8] = {bflo(ah.x) + bflo(al.x), bfhi(ah.x) + bfhi(al.x), bflo(ah.y) + bflo(al.y), bfhi(ah.y) + bfhi(al.y), bflo(ah.z) + bflo(al.z), bfhi(ah.z) + bfhi(al.z), bflo(ah.w) + bflo(al.w), bfhi(ah.w) + bfhi(al.w)};
#if MOE_FP8
                float ys[8] = {0.f, 0.f, 0.f, 0.f, 0.f, 0.f, 0.f, 0.f};
#pragma unroll
                for (int k = 0; k < 4; ++k) { const u32x2 y = __builtin_nontemporal_load((const u32x2*)((const unsigned char*)(ws + WS_Y) + (size_t)rowk[k] * D + c)); float lo[4], hi[4]; unpack4_fp8(y.x, lo); unpack4_fp8(y.y, hi);
#pragma unroll
                    for (int i = 0; i < 4; ++i) { ys[i] += lo[i]; ys[4 + i] += hi[i]; } }
#pragma unroll
                for (int i = 0; i < 8; ++i) v[i] += ys[i] * (1.f / F8_YSCALE);
#else
#pragma unroll
                for (int k = 0; k < 4; ++k) { const u32x4 y = *(const u32x4*)((const bf16_t*)(ws + WS_Y) + (size_t)rowk[k] * D + c);
                    v[0] += bflo(y.x); v[1] += bfhi(y.x); v[2] += bflo(y.y); v[3] += bfhi(y.y); v[4] += bflo(y.z); v[5] += bfhi(y.z); v[6] += bflo(y.w); v[7] += bfhi(y.w); }
#endif
                u32x4 w; w.x = cvt_pk_bf16(v[0], v[1]); w.y = cvt_pk_bf16(v[2], v[3]); w.z = cvt_pk_bf16(v[4], v[5]); w.w = cvt_pk_bf16(v[6], v[7]);
                *(u32x4*)(X2B + (size_t)t * D + c) = w;
#if MOE_FP8
                u32x2 w8; w8.x = pack4_fp8c(v[0] * F8_XSCALE, v[1] * F8_XSCALE, v[2] * F8_XSCALE, v[3] * F8_XSCALE); w8.y = pack4_fp8c(v[4] * F8_XSCALE, v[5] * F8_XSCALE, v[6] * F8_XSCALE, v[7] * F8_XSCALE);
                *(u32x2*)(X2F8 + (size_t)t * D + c) = w8;
#endif
#pragma unroll
                for (int i = 0; i < 8; ++i) s += v[i] * v[i];
            }
            s = wave_sum(s);
            if (lane == 0) rstd2[t] = rsqrtf(s * (1.f / D) + RMS_EPS);
          }
        }
        __syncthreads();
        pg8::Gemm g{PB, WppT, nullptr, 0, PLE, 0}; pg8::StaticOrder S; S.init(T, D, G, bx);
        pg8::EpiBf16 E{(bf16_t*)(ws + WS_PLEB), D};
        pg8::gemm_phase<pg8::EpiBf16, pg8::StaticOrder, false>(lds + RING_OFF, g, S, E);
        if (BOTH(9)) xcd_barrier(bar);
    }
    if (IN(10)) {
        pg8::Gemm g{MOE_FP8 ? (const bf16_t*)(ws + WS_X2) : (const bf16_t*)(ws + WS_X2B), WpgT, nullptr, 0, D / (MOE_FP8 ? 2 : 1), 0};
        if (G == 256) {
            pg8::StaticOrder S; S.init(T, D, G, bx, 0, 1 << 30, 4);
            pg8::EpiPleGateNorm E{(const bf16_t*)(ws + WS_X2B), (const float*)(ws + WS_RSTD), (const bf16_t*)(ws + WS_PLEB), args.out, (float*)(ctl + CW_SSQ), (unsigned*)(ctl + CW_PCNT), args.in[21]};
            pg8::gemm_phase<pg8::EpiPleGateNorm, pg8::StaticOrder, false, MOE_FP8 != 0>(lds + RING_OFF, g, S, E);
        } else {
            pg8::StaticOrder S; S.init(T, D, G, bx);
            pg8::EpiPleGate E{(const bf16_t*)(ws + WS_X2B), (const float*)(ws + WS_RSTD), (const bf16_t*)(ws + WS_PLEB), XN  , (float*)(ctl + CW_SSQ)};
            pg8::gemm_phase<pg8::EpiPleGate, pg8::StaticOrder, false, MOE_FP8 != 0>(lds + RING_OFF, g, S, E);
            if (BOTH(10)) xcd_barrier(bar);
        }
    }
    if (IN(11) && G != 256) {
        const float* ssq = (const float*)(ctl + CW_SSQ);
        for (int m = gw; m < T; m += NGW) {
            const float rr = rsqrtf(ld_agent_f(ssq + m) * (1.f / D) + RMS_EPS);
#pragma unroll
            for (int j = 0; j < 4; ++j) { const size_t c = (size_t)8 * lane + 512 * j; const u32x4 xw = *(const u32x4*)(XN + (size_t)m * D + c);
                const f32x4 g0 = *(const f32x4*)(args.in[21] + c), g1 = *(const f32x4*)(args.in[21] + c + 4);
                f32x4 o0, o1; o0[0] = bflo(xw.x) * rr * g0[0]; o0[1] = bfhi(xw.x) * rr * g0[1]; o0[2] = bflo(xw.y) * rr * g0[2]; o0[3] = bfhi(xw.y) * rr * g0[3];
                o1[0] = bflo(xw.z) * rr * g1[0]; o1[1] = bfhi(xw.z) * rr * g1[1]; o1[2] = bflo(xw.w) * rr * g1[2]; o1[3] = bfhi(xw.w) * rr * g1[3];
                *(f32x4*)(args.out + (size_t)m * D + c) = o0; *(f32x4*)(args.out + (size_t)m * D + c + 4) = o1; }
        }
    }
#undef IN
#undef BOTH
}

static int g_grid = 0;
static void mk(hipStream_t st, const Args& base, int lo, int hi, int li = 0) {
    Args a = base; a.ph_lo = lo; a.ph_hi = hi; a.li = li;
    hipLaunchKernelGGL(mk_fwd, dim3(g_grid), dim3(NWAVES * 64), LDS_BYTES, st, a);
}

extern "C" void kernel_launch(void* const* d_in, const int* in_sizes, int n_in, void* d_out, int out_size, void* d_ws, size_t ws_size, hipStream_t stream) {
    if (g_grid == 0) {
        int dev = 0, cus = 0;
        if (hipGetDevice(&dev) != hipSuccess || hipDeviceGetAttribute(&cus, hipDeviceAttributeMultiprocessorCount, dev) != hipSuccess) { fprintf(stderr, "kernel_launch: device query failed\n"); g_grid = -1; return; }
        if (hipFuncSetAttribute((const void*)mk_fwd, hipFuncAttributeMaxDynamicSharedMemorySize, LDS_BYTES) != hipSuccess) { fprintf(stderr, "kernel_launch: hipFuncSetAttribute failed\n"); g_grid = -1; return; }
        int per_cu = 0;
        if (hipOccupancyMaxActiveBlocksPerMultiprocessor(&per_cu, (const void*)mk_fwd, NWAVES * 64, LDS_BYTES) != hipSuccess || per_cu < 1) fprintf(stderr, "kernel_launch: occupancy query says %d per CU\n", per_cu);
        (void)hipGetLastError();
        g_grid = cus;
    }
    if (g_grid < 0) return;
    if (WS_END > ws_size) { fprintf(stderr, "kernel_launch: workspace too small (%zu)\n", ws_size); return; }
    char* ws = (char*)d_ws; float* out = (float*)d_out;
    Args a{};
    for (int i = 0; i < 22; ++i) a.in[i] = (const float*)d_in[i];
    a.out = out; a.ws = (unsigned char*)d_ws;
    (void)hipMemsetAsync(ws + WS_CTL, 0, CTL_ZERO_BYTES, stream);
    mk(stream, a, 0, 12);
}
```

```cpp
#include <hip/hip_runtime.h>
#include <cstdio>
#include <cstdint>

constexpr int BATCH = 4, SEQ = 4096, T = BATCH * SEQ, D = 2048;
constexpr int HG_H = 8, HG_DK = 128, HG_DV = 128, HG_K = 1024, HG_V = 1024;
constexpr int GM_G = 8, GM_CH = 128, GM_W = 1024, GM_CHUNK = 128;
constexpr int IN_W = 6144;
constexpr int ZQ = 0, ZF = 1024, ZI = 2048, ZG = 3072, ZU = 4096, ZV = 5120;
constexpr int NE = 32, TOPK = 4, DFF = 2048;
constexpr int PLE = 256;
constexpr float RMS_EPS = 1e-6f, LN_EPS = 1e-5f;
constexpr int MT = 128;
constexpr int MAXTILES = 576, RMAX = MAXTILES * MT;

__device__ __forceinline__ float gelu_erf(float x) { return 0.5f * x * (1.f + erff(x * 0.70710678118f)); }
__device__ __forceinline__ float sigmoidf(float x) { return 1.f / (1.f + expf(-x)); }
__device__ __forceinline__ float wave_sum(float v) {
#pragma unroll
    for (int o = 32; o >= 1; o >>= 1) v += __shfl_xor(v, o);
    return v;
}

#define LAS __attribute__((address_space(3)))
#define GAS __attribute__((address_space(1)))
typedef unsigned short bf16_t;
typedef short bf16x8 __attribute__((ext_vector_type(8)));
typedef float f32x4 __attribute__((ext_vector_type(4)));
typedef float f32x2 __attribute__((ext_vector_type(2)));
typedef unsigned u32x4 __attribute__((ext_vector_type(4)));
typedef unsigned u32x2 __attribute__((ext_vector_type(2)));
typedef GAS unsigned gu32;
#define RLX_AGENT __ATOMIC_RELAXED, __HIP_MEMORY_SCOPE_AGENT
#define LDS_WAIT() asm volatile("s_waitcnt lgkmcnt(0)" ::: "memory")
#define VM_WAIT() asm volatile("s_waitcnt vmcnt(0)" ::: "memory")

typedef __bf16 bf16x2_t __attribute__((ext_vector_type(2)));
__device__ __forceinline__ unsigned cvt_pk_bf16(float lo, float hi) { f32x2 v = {lo, hi}; bf16x2_t b = __builtin_convertvector(v, bf16x2_t); return __builtin_bit_cast(unsigned, b); }
__device__ __forceinline__ float bf2f(unsigned short b) { return __uint_as_float(((unsigned)b) << 16); }
__device__ __forceinline__ float bflo(unsigned w) { return __uint_as_float(w << 16); }
__device__ __forceinline__ float bfhi(unsigned w) { return __uint_as_float(w & 0xffff0000u); }
__device__ __forceinline__ unsigned short f2bf(float f) { return (unsigned short)__builtin_bit_cast(unsigned short, (__bf16)f); }
__device__ __forceinline__ float fast_sigmoid(float x) { return __builtin_amdgcn_rcpf(1.f + __builtin_amdgcn_exp2f(-1.44269504f * x)); }

__device__ __forceinline__ float fast_exp(float x) { return __builtin_amdgcn_exp2f(1.44269504f * x); }
__device__ __forceinline__ float fast_log(float x) { return 0.69314718f * __builtin_amdgcn_logf(x); }
__device__ __forceinline__ float gelu_fast(float v) {
    const float av = fabsf(v), t = __builtin_amdgcn_rcpf(1.0f + 0.2316418882f * av);
    float q = t * 0.5307027145f + (-0.7265760135f); q = q * t + 0.7107068705f; q = q * t + (-0.142248368f); q = q * t + 0.127414796f; q = q * t;
    const float e = __builtin_amdgcn_exp2f((v * v) * (-0.72134752044f)), m = v * (q * e);
    return v < 0.f ? m : v - m;
}
__device__ __forceinline__ float ld_agent_f(const float* p) { return __uint_as_float(__hip_atomic_load((const unsigned*)p, __ATOMIC_RELAXED, __HIP_MEMORY_SCOPE_AGENT)); }
__device__ __forceinline__ int ld_agent_i(const int* p) { return (int)__hip_atomic_load((const unsigned*)p, __ATOMIC_RELAXED, __HIP_MEMORY_SCOPE_AGENT); }
__device__ __forceinline__ unsigned pack4_fp8(float a, float b, float c, float d) { int r = __builtin_amdgcn_cvt_pk_fp8_f32(a, b, 0, false); r = __builtin_amdgcn_cvt_pk_fp8_f32(c, d, r, true); return (unsigned)r; }
__device__ __forceinline__ float clamp_f8(float v) { return __builtin_amdgcn_fmed3f(v, -440.f, 440.f); }
__device__ __forceinline__ unsigned pack4_fp8c(float a, float b, float c, float d) { return pack4_fp8(clamp_f8(a), clamp_f8(b), clamp_f8(c), clamp_f8(d)); }
typedef float f32x2u __attribute__((ext_vector_type(2)));
__device__ __forceinline__ void unpack4_fp8(unsigned w, float (&o)[4]) { const f32x2u lo = __builtin_amdgcn_cvt_pk_f32_fp8((int)w, false), hi = __builtin_amdgcn_cvt_pk_f32_fp8((int)w, true); o[0] = lo[0]; o[1] = lo[1]; o[2] = hi[0]; o[3] = hi[1]; }
#ifndef MOE_FP8
#define MOE_FP8 1
#endif
constexpr float F8_WSCALE = 256.f, F8_XSCALE = 16.f, F8_ASCALE = 4.f, F8_YSCALE = 64.f, F8_MSCALE = 8.f;
#ifndef OUT_FP8
#define OUT_FP8 0
#endif
#ifndef F8_MFMA_SCALE
#define F8_MFMA_SCALE 0
#endif
typedef int i32x8 __attribute__((ext_vector_type(8)));
typedef int i32x4 __attribute__((ext_vector_type(4)));
#ifndef X1_LO
#define X1_LO 0
#endif
#ifndef NT_MASK
#define NT_MASK 26
#endif
#define NTLD(g, p) (((NT_MASK >> (g)) & 1) ? __builtin_nontemporal_load(p) : *(p))
#ifndef MOE_WGM
#define MOE_WGM 4
#endif
constexpr int LISTCAP = T;
constexpr int MOE_MAXTILES = 288;
constexpr int MOE_RMAX = MOE_MAXTILES * 256;

namespace pg8 {
constexpr int BM = 256, BK = 64, HALF = 128, HTB = HALF * BK * 2  , STAGE_BYTES = 8 * HTB, NXCD = 8, WGM = 8;
__host__ __device__ __forceinline__ int lds_byte(int r, int c) { const int st = (r >> 4) * 2 + (c >> 5), rr = r & 15, cc = c & 31, ob = rr * 64 + cc * 2; return st * 1024 + (ob ^ (((ob >> 9) & 1) << 5)); }
__host__ __device__ __forceinline__ void stage_rc(int b, int& R, int& C) { const int st = b / 1024, sb = b % 1024, swz = sb ^ (((sb >> 9) & 1) << 5); R = (st >> 1) * 16 + swz / 64; C = (st & 1) * 32 + (swz % 64) / 2; }
__host__ __device__ __forceinline__ int perm32(int rho) { const int n = rho >> 4, i = rho & 15; return 8 * (i >> 2) + 4 * n + (i & 3); }

struct Unit { int pm, pn, e, gbase; };
struct Gemm { const bf16_t* A; const bf16_t* Bt; const int* rowidx; long long strideE; int K; int maxrow; };

__device__ __forceinline__ bool tile_order(int i, int G, int c, int nM, int nN, int& pm, int& pn, int wgm = WGM) {
    const int nwg = nM * nN; const long L = (long)i * G + c; if (L >= nwg) return false;
    int wgid = (int)L; { const int q = nwg / NXCD, r = nwg % NXCD, xcd = wgid % NXCD, off = wgid / NXCD; wgid = (xcd < r ? xcd * (q + 1) : r * (q + 1) + (xcd - r) * q) + off; }
    const int nig = wgm * nN, gid = wgid / nig, fm = gid * wgm, gsz = (nM - fm) < wgm ? (nM - fm) : wgm;
    pm = fm + ((wgid % nig) % gsz); pn = (wgid % nig) / gsz; return true;
}
struct StaticOrder {
    int nM, nN, G, c, i0, nr, wgm;
    __device__ void init(int M, int N, int G_, int c_, int i0_ = 0, int nr_ = 1 << 30, int wgm_ = WGM) { nM = M / BM; nN = N / BM; G = G_; c = c_; i0 = i0_; nr = nr_; wgm = wgm_; }
    __device__ __forceinline__ bool next(int i, Unit& u) const { u.e = 0; u.gbase = 0; if (i >= nr) return false; return tile_order(i + i0, G, c, nM, nN, u.pm, u.pn, wgm); }
};
struct MoeOrder {
    int nM, nN, G, c; const LAS int* tile_e; const LAS int* tstart;
    __device__ __forceinline__ bool next(int i, Unit& u) const {
        if (!tile_order(i, G, c, nM, nN, u.pm, u.pn, MOE_WGM)) return false;
        const int e = __builtin_amdgcn_readfirstlane(tile_e[u.pm]); u.e = e;
        u.gbase = e * LISTCAP + (u.pm - __builtin_amdgcn_readfirstlane(tstart[e])) * BM; return true;
    }
};

struct EpiBf16 {
    static constexpr bool ACC_INIT = false;
    bf16_t* O; int ldc;
    __device__ __forceinline__ void operator()(const f32x4 (&acc)[2][2][4][2], const Unit& u, int wr, int wc, int fr, int fq) const {
        bf16_t* base = O + (size_t)(u.pm * BM + wr * 64 + fr) * ldc + u.pn * BM + wc * 32 + 8 * fq;
#pragma unroll
        for (int ai = 0; ai < 2; ++ai)
#pragma unroll
            for (int m = 0; m < 4; ++m) { bf16_t* rowp = base + (size_t)(ai * HALF + m * 16) * ldc;
#pragma unroll
                for (int bj = 0; bj < 2; ++bj) { const f32x4 v0 = acc[ai][bj][m][0], v1 = acc[ai][bj][m][1];
                    u32x4 w; w.x = cvt_pk_bf16(v0[0], v0[1]); w.y = cvt_pk_bf16(v0[2], v0[3]); w.z = cvt_pk_bf16(v1[0], v1[1]); w.w = cvt_pk_bf16(v1[2], v1[3]);
                    *(u32x4*)(rowp + bj * HALF) = w; } }
    }
};
struct EpiResF32Bf16 {
    static constexpr bool ACC_INIT = true;
    const float* res; bf16_t* XH; bf16_t* XL; bf16_t* XB;
    __device__ __forceinline__ void init(f32x4 (&acc)[2][2][4][2], const Unit& u, int wr, int wc, int fr, int fq) const {
        const size_t o0 = (size_t)(u.pm * BM + wr * 64 + fr) * D + u.pn * BM + wc * 32 + 8 * fq;
#pragma unroll
        for (int ai = 0; ai < 2; ++ai)
#pragma unroll
            for (int m = 0; m < 4; ++m)
#pragma unroll
                for (int bj = 0; bj < 2; ++bj) { const size_t o = o0 + (size_t)(ai * HALF + m * 16) * D + bj * HALF; acc[ai][bj][m][0] = NTLD(1, (const f32x4*)(res + o)); acc[ai][bj][m][1] = NTLD(1, (const f32x4*)(res + o + 4)); }
    }
    __device__ __forceinline__ void operator()(const f32x4 (&acc)[2][2][4][2], const Unit& u, int wr, int wc, int fr, int fq) const {
        const size_t o0 = (size_t)(u.pm * BM + wr * 64 + fr) * D + u.pn * BM + wc * 32 + 8 * fq;
#pragma unroll
        for (int ai = 0; ai < 2; ++ai)
#pragma unroll
            for (int m = 0; m < 4; ++m) { const size_t o = o0 + (size_t)(ai * HALF + m * 16) * D;
#pragma unroll
                for (int bj = 0; bj < 2; ++bj) {
                    const f32x4 v0 = acc[ai][bj][m][0], v1 = acc[ai][bj][m][1];
                    u32x4 wh; wh.x = cvt_pk_bf16(v0[0], v0[1]); wh.y = cvt_pk_bf16(v0[2], v0[3]); wh.z = cvt_pk_bf16(v1[0], v1[1]); wh.w = cvt_pk_bf16(v1[2], v1[3]);
                    u32x4 wl; wl.x = cvt_pk_bf16(v0[0] - bflo(wh.x), v0[1] - bfhi(wh.x)); wl.y = cvt_pk_bf16(v0[2] - bflo(wh.y), v0[3] - bfhi(wh.y)); wl.z = cvt_pk_bf16(v1[0] - bflo(wh.z), v1[1] - bfhi(wh.z)); wl.w = cvt_pk_bf16(v1[2] - bflo(wh.w), v1[3] - bfhi(wh.w));
                    *(u32x4*)(XH + o + bj * HALF) = wh; if (X1_LO) *(u32x4*)(XL + o + bj * HALF) = wl;
#if MOE_FP8
                    u32x2 w; w.x = pack4_fp8c(v0[0] * F8_XSCALE, v0[1] * F8_XSCALE, v0[2] * F8_XSCALE, v0[3] * F8_XSCALE); w.y = pack4_fp8c(v1[0] * F8_XSCALE, v1[1] * F8_XSCALE, v1[2] * F8_XSCALE, v1[3] * F8_XSCALE);
                    *(u32x2*)((unsigned char*)XB + o + bj * HALF) = w; }
#endif
            }
    }
};
struct EpiSwiglu {
    static constexpr bool ACC_INIT = false;
    bf16_t* ACT; const float* rs; const float* bgu;
    __device__ __forceinline__ void operator()(const f32x4 (&acc)[2][2][4][2], const Unit& u, int wr, int wc, int fr, int fq) const {
        const int a0 = u.pn * HALF + wc * 32 + 8 * fq;
        const float* bp = bgu + (size_t)u.e * (2 * DFF) + 2 * a0;
        const f32x4 b0 = *(const f32x4*)bp, b1 = *(const f32x4*)(bp + 4), b2 = *(const f32x4*)(bp + 8), b3 = *(const f32x4*)(bp + 12);
        const float bg[8] = {b0[0], b0[2], b1[0], b1[2], b2[0], b2[2], b3[0], b3[2]}, bu[8] = {b0[1], b0[3], b1[1], b1[3], b2[1], b2[3], b3[1], b3[3]};
        const float* rsp = rs + u.gbase + wr * 64 + fr;
        bf16_t* base = ACT + (size_t)(u.pm * BM + wr * 64 + fr) * DFF + a0;
        float scv[2][4];
#pragma unroll
        for (int ai = 0; ai < 2; ++ai)
#pragma unroll
            for (int m = 0; m < 4; ++m) scv[ai][m] = rsp[ai * HALF + m * 16];
#pragma unroll
        for (int ai = 0; ai < 2; ++ai)
#pragma unroll
            for (int m = 0; m < 4; ++m) { const float sc = scv[ai][m] * (MOE_FP8 ? 1.f / (F8_WSCALE * F8_XSCALE) : 1.f); float a[8];
#pragma unroll
                for (int n = 0; n < 2; ++n)
#pragma unroll
                    for (int j = 0; j < 4; ++j) { const float g = fminf(acc[ai][0][m][n][j] * sc + bg[4 * n + j], 7.f), up = fminf(fmaxf(acc[ai][1][m][n][j] * sc + bu[4 * n + j], -7.f), 7.f);
                        a[4 * n + j] = (up + 1.f) * g * fast_sigmoid(1.702f * g); }
#if MOE_FP8
                u32x2 w; w.x = pack4_fp8c(a[0] * F8_ASCALE, a[1] * F8_ASCALE, a[2] * F8_ASCALE, a[3] * F8_ASCALE); w.y = pack4_fp8c(a[4] * F8_ASCALE, a[5] * F8_ASCALE, a[6] * F8_ASCALE, a[7] * F8_ASCALE);
                *(u32x2*)((unsigned char*)ACT + (size_t)(u.pm * BM + wr * 64 + fr + ai * HALF + m * 16) * DFF + a0) = w; }
#else
                u32x4 w; w.x = cvt_pk_bf16(a[0], a[1]); w.y = cvt_pk_bf16(a[2], a[3]); w.z = cvt_pk_bf16(a[4], a[5]); w.w = cvt_pk_bf16(a[6], a[7]);
                *(u32x4*)(base + (size_t)(ai * HALF + m * 16) * DFF) = w; }
#endif
    }
};
struct EpiDown {
    static constexpr bool ACC_INIT = false;
    bf16_t* Y; const float* gt; const float* bdn;
    __device__ __forceinline__ void operator()(const f32x4 (&acc)[2][2][4][2], const Unit& u, int wr, int wc, int fr, int fq) const {
        const int c0 = u.pn * BM + wc * 32 + 8 * fq;
        const float* bp = bdn + (size_t)u.e * D + c0;
        f32x4 bv[2][2];
#pragma unroll
        for (int bj = 0; bj < 2; ++bj) { bv[bj][0] = *(const f32x4*)(bp + bj * HALF); bv[bj][1] = *(const f32x4*)(bp + bj * HALF + 4); }
        const float* gp = gt + u.gbase + wr * 64 + fr;
        bf16_t* base = Y + (size_t)(u.pm * BM + wr * 64 + fr) * D + c0;
        float ggv[2][4];
#pragma unroll
        for (int ai = 0; ai < 2; ++ai)
#pragma unroll
            for (int m = 0; m < 4; ++m) ggv[ai][m] = gp[ai * HALF + m * 16];
#pragma unroll
        for (int ai = 0; ai < 2; ++ai)
#pragma unroll
            for (int m = 0; m < 4; ++m) { const float gg = ggv[ai][m]; bf16_t* rowp = base + (size_t)(ai * HALF + m * 16) * D;
#pragma unroll
                for (int bj = 0; bj < 2; ++bj) { const float ds = MOE_FP8 ? 1.f / (F8_WSCALE * F8_ASCALE) : 1.f; const f32x4 v0 = (acc[ai][bj][m][0] * ds + bv[bj][0]) * gg, v1 = (acc[ai][bj][m][1] * ds + bv[bj][1]) * gg;
#if MOE_FP8
                    u32x2 w; w.x = pack4_fp8c(v0[0] * F8_YSCALE, v0[1] * F8_YSCALE, v0[2] * F8_YSCALE, v0[3] * F8_YSCALE); w.y = pack4_fp8c(v1[0] * F8_YSCALE, v1[1] * F8_YSCALE, v1[2] * F8_YSCALE, v1[3] * F8_YSCALE);
                    *(u32x2*)((unsigned char*)Y + (size_t)(u.pm * BM + wr * 64 + fr + ai * HALF + m * 16) * D + c0 + bj * HALF) = w; } }
#else
                    u32x4 w; w.x = cvt_pk_bf16(v0[0], v0[1]); w.y = cvt_pk_bf16(v0[2], v0[3]); w.z = cvt_pk_bf16(v1[0], v1[1]); w.w = cvt_pk_bf16(v1[2], v1[3]);
                    *(u32x4*)(rowp + bj * HALF) = w; } }
#endif
    }
};
struct EpiPleGate {
    static constexpr bool ACC_INIT = false;
    const bf16_t* X2B; const float* rstd2; const bf16_t* PLEB; bf16_t* X3B; float* ssq;
    __device__ __forceinline__ void operator()(const f32x4 (&acc)[2][2][4][2], const Unit& u, int wr, int wc, int fr, int fq) const {
        const int row0 = u.pm * BM + wr * 64 + fr;
        const size_t o0 = (size_t)row0 * D + u.pn * BM + wc * 32 + 8 * fq;
#pragma unroll
        for (int ai = 0; ai < 2; ++ai) {
            u32x4 xw[4][2], pw[4][2]; float rsv[4];
#pragma unroll
            for (int m = 0; m < 4; ++m) { rsv[m] = rstd2[row0 + ai * HALF + m * 16];
#pragma unroll
                for (int bj = 0; bj < 2; ++bj) { const size_t o = o0 + (size_t)(ai * HALF + m * 16) * D + bj * HALF; xw[m][bj] = *(const u32x4*)(X2B + o); pw[m][bj] = *(const u32x4*)(PLEB + o); } }
#pragma unroll
            for (int m = 0; m < 4; ++m) { const size_t o = o0 + (size_t)(ai * HALF + m * 16) * D; const float rs = rsv[m] * (MOE_FP8 ? 1.f / (F8_WSCALE * F8_XSCALE) : 1.f); float s = 0.f;
#pragma unroll
                for (int bj = 0; bj < 2; ++bj) { const u32x4 xq = xw[m][bj], pq = pw[m][bj];
                    const float xv[8] = {bflo(xq.x), bfhi(xq.x), bflo(xq.y), bfhi(xq.y), bflo(xq.z), bfhi(xq.z), bflo(xq.w), bfhi(xq.w)};
                    const float pl[8] = {bflo(pq.x), bfhi(pq.x), bflo(pq.y), bfhi(pq.y), bflo(pq.z), bfhi(pq.z), bflo(pq.w), bfhi(pq.w)};
                    float v[8];
#pragma unroll
                    for (int j = 0; j < 4; ++j) { v[j] = xv[j] + fast_sigmoid(acc[ai][bj][m][0][j] * rs) * pl[j]; v[4 + j] = xv[4 + j] + fast_sigmoid(acc[ai][bj][m][1][j] * rs) * pl[4 + j]; s += v[j] * v[j] + v[4 + j] * v[4 + j]; }
                    u32x4 w; w.x = cvt_pk_bf16(v[0], v[1]); w.y = cvt_pk_bf16(v[2], v[3]); w.z = cvt_pk_bf16(v[4], v[5]); w.w = cvt_pk_bf16(v[6], v[7]);
                    *(u32x4*)(X3B + o + bj * HALF) = w; }
                s += __shfl_xor(s, 16); s += __shfl_xor(s, 32);
                if (fq == 0) atomicAdd(ssq + row0 + ai * HALF + m * 16, s); }
            asm volatile("" ::: "memory"); }
    }
};

struct EpiPleGateNorm {
    static constexpr bool ACC_INIT = false;
    const bf16_t* X2B; const float* rstd2; const bf16_t* PLEB; float* out; float* ssq; unsigned* pcnt; const float* gfin;
    __device__ __forceinline__ void operator()(f32x4 (&acc)[2][2][4][2], const Unit& u, int wr, int wc, int fr, int fq) const {
        const int row0 = u.pm * BM + wr * 64 + fr;
        const size_t o0 = (size_t)row0 * D + u.pn * BM + wc * 32 + 8 * fq;
#pragma unroll
        for (int ai = 0; ai < 2; ++ai) {
            u32x4 xw[4][2], pw[4][2]; float rsv[4];
#pragma unroll
            for (int m = 0; m < 4; ++m) { rsv[m] = rstd2[row0 + ai * HALF + m * 16];
#pragma unroll
                for (int bj = 0; bj < 2; ++bj) { const size_t o = o0 + (size_t)(ai * HALF + m * 16) * D + bj * HALF; xw[m][bj] = NTLD(0, (const u32x4*)(X2B + o)); pw[m][bj] = NTLD(0, (const u32x4*)(PLEB + o)); } }
#pragma unroll
            for (int m = 0; m < 4; ++m) { const float rs = rsv[m] * (MOE_FP8 ? 1.f / (F8_WSCALE * F8_XSCALE) : 1.f); float s = 0.f;
#pragma unroll
                for (int bj = 0; bj < 2; ++bj) { const u32x4 xq = xw[m][bj], pq = pw[m][bj];
                    const float xv[8] = {bflo(xq.x), bfhi(xq.x), bflo(xq.y), bfhi(xq.y), bflo(xq.z), bfhi(xq.z), bflo(xq.w), bfhi(xq.w)};
                    const float pl[8] = {bflo(pq.x), bfhi(pq.x), bflo(pq.y), bfhi(pq.y), bflo(pq.z), bfhi(pq.z), bflo(pq.w), bfhi(pq.w)};
#pragma unroll
                    for (int j = 0; j < 4; ++j) { const float v0 = xv[j] + fast_sigmoid(acc[ai][bj][m][0][j] * rs) * pl[j], v1 = xv[4 + j] + fast_sigmoid(acc[ai][bj][m][1][j] * rs) * pl[4 + j];
                        acc[ai][bj][m][0][j] = v0; acc[ai][bj][m][1][j] = v1; s += v0 * v0 + v1 * v1; } }
                s += __shfl_xor(s, 16); s += __shfl_xor(s, 32);
                if (fq == 0) atomicAdd(ssq + row0 + ai * HALF + m * 16, s); }
            asm volatile("" ::: "memory"); }
        asm volatile("s_waitcnt vmcnt(0)" ::: "memory");
        __builtin_amdgcn_s_barrier();
        if (threadIdx.x == 0) {
            unsigned* pc = pcnt + 64 * u.pm;
            (void)__hip_atomic_fetch_add(pc, 1u, __ATOMIC_RELAXED, __HIP_MEMORY_SCOPE_AGENT);
            for (unsigned sp = 0; __hip_atomic_load(pc, __ATOMIC_RELAXED, __HIP_MEMORY_SCOPE_AGENT) < (unsigned)(D / BM) && sp < (1u << 20); ++sp) __builtin_amdgcn_s_sleep(1);
        }
        asm volatile("" ::: "memory"); __builtin_amdgcn_s_barrier(); asm volatile("" ::: "memory");
        const int c0 = u.pn * BM + wc * 32 + 8 * fq;
        f32x4 gv[2][2];
#pragma unroll
        for (int bj = 0; bj < 2; ++bj) { gv[bj][0] = *(const f32x4*)(gfin + c0 + bj * HALF); gv[bj][1] = *(const f32x4*)(gfin + c0 + bj * HALF + 4); }
        float rr[2][4];
#pragma unroll
        for (int ai = 0; ai < 2; ++ai)
#pragma unroll
            for (int m = 0; m < 4; ++m) rr[ai][m] = rsqrtf(ld_agent_f(ssq + row0 + ai * HALF + m * 16) * (1.f / D) + RMS_EPS);
#pragma unroll
        for (int ai = 0; ai < 2; ++ai)
#pragma unroll
            for (int m = 0; m < 4; ++m) { const size_t o = o0 + (size_t)(ai * HALF + m * 16) * D;
#pragma unroll
                for (int bj = 0; bj < 2; ++bj) { const f32x4 w0 = acc[ai][bj][m][0] * rr[ai][m] * gv[bj][0], w1 = acc[ai][bj][m][1] * rr[ai][m] * gv[bj][1]; if ((NT_MASK >> 5) & 1) { __builtin_nontemporal_store(w0, (f32x4*)(out + o + bj * HALF)); __builtin_nontemporal_store(w1, (f32x4*)(out + o + bj * HALF + 4)); } else { *(f32x4*)(out + o + bj * HALF) = w0; *(f32x4*)(out + o + bj * HALF + 4) = w1; } } }
    }
};

template <class Epi, class Sched, bool GATHER, bool FP8 = false>
__device__ __forceinline__ void gemm_phase(LAS unsigned char* lds, const Gemm g, const Sched& S, const Epi& E) {
    const int tid = threadIdx.x, wid = __builtin_amdgcn_readfirstlane(tid >> 6), lane = tid & 63, wr = wid >> 2, wc = wid & 3, fr = lane & 15, fq = lane >> 4;
    const int K = g.K, nt = K / BK;
    unsigned voffB[2];
#pragma unroll
    for (int i = 0; i < 2; ++i) { int R, C; stage_rc(tid * 16 + i * 8192, R, C); const int Rb = (R & ~31) + perm32(R & 31); voffB[i] = (unsigned)(Rb * K + C) * 2u; }
    const size_t kstep = (size_t)(BK * 2);
    const size_t hstep = (size_t)HALF * K * 2;
    const size_t tstep = 2 * hstep;
    const unsigned ldsw = (unsigned)wid * 1024u;
    const int aoff = lds_byte(wr * 64 + fr, fq * 8), boff = lds_byte(wc * 32 + fr, fq * 8);
    const char* Ab = (const char*)g.A;
#define PG8_SA(b, h) (((b) * 2 + (h)) * HTB)
#define PG8_SB(b, h) ((4 + (b) * 2 + (h)) * HTB)
#define PG8_STAGE(bufoff, gbase, voff) do { _Pragma("unroll") for (int _i = 0; _i < 2; ++_i) \
        __builtin_amdgcn_global_load_lds((const unsigned*)((const char*)(gbase) + (voff)[_i]), (LAS unsigned*)(lds + (bufoff) + ldsw + _i * 8192), 16, 0, 0); } while (0)
#define PG8_STAGE_A(bufoff, VO, h, koff) do { const char* _ab = Ab + (size_t)(koff); asm volatile("" : "+s"(_ab)); _Pragma("unroll") for (int _i = 0; _i < 2; ++_i) \
        __builtin_amdgcn_global_load_lds((const unsigned*)(_ab + (VO)[h][_i]), (LAS unsigned*)(lds + (bufoff) + ldsw + _i * 8192), 16, 0, 0); } while (0)
#define PG8_LOAD_VO(VO, U) do { int _t = tid; asm volatile("" : "+v"(_t)); _Pragma("unroll") for (int _i = 0; _i < 2; ++_i) { int _R, _C; stage_rc(_t * 16 + _i * 8192, _R, _C); _Pragma("unroll") for (int _h = 0; _h < 2; ++_h) { \
        unsigned _row; if (GATHER) { _row = (unsigned)g.rowidx[(U).gbase + _h * HALF + _R]; _row = _row < (unsigned)g.maxrow ? _row : (unsigned)g.maxrow; } else _row = (unsigned)((U).pm * BM + _h * HALF + _R); \
        (VO)[_h][_i] = (_row * (unsigned)K + (unsigned)_C) * 2u; } } } while (0)
#define PG8_LDA(dst, b, h) do { _Pragma("unroll") for (int m = 0; m < 4; ++m) { if constexpr (FP8) { const i32x4 _l = *(const LAS i32x4*)(lds + PG8_SA(b, h) + aoff + m * 2048), _h = *(const LAS i32x4*)(lds + PG8_SA(b, h) + aoff + m * 2048 + 1024); \
            dst##8[m] = __builtin_shufflevector(_l, _h, 0, 1, 2, 3, 4, 5, 6, 7); } else { _Pragma("unroll") for (int k = 0; k < 2; ++k) dst[m][k] = *(const LAS bf16x8*)(lds + PG8_SA(b, h) + aoff + m * 2048 + k * 1024); } } } while (0)
#define PG8_LDB(dst, b, h) do { _Pragma("unroll") for (int n = 0; n < 2; ++n) { if constexpr (FP8) { const i32x4 _l = *(const LAS i32x4*)(lds + PG8_SB(b, h) + boff + n * 2048), _h = *(const LAS i32x4*)(lds + PG8_SB(b, h) + boff + n * 2048 + 1024); \
            dst##8[n] = __builtin_shufflevector(_l, _h, 0, 1, 2, 3, 4, 5, 6, 7); } else { _Pragma("unroll") for (int k = 0; k < 2; ++k) dst[n][k] = *(const LAS bf16x8*)(lds + PG8_SB(b, h) + boff + n * 2048 + k * 1024); } } } while (0)
#define PG8_MMA(ai, bj, At, Bt) do { __builtin_amdgcn_s_setprio(1); _Pragma("unroll") for (int m = 0; m < 4; ++m) _Pragma("unroll") for (int n = 0; n < 2; ++n) { \
        if constexpr (FP8) acc[ai][bj][m][n] = __builtin_amdgcn_mfma_scale_f32_16x16x128_f8f6f4(Bt##8[n], At##8[m], acc[ai][bj][m][n], 0, 0, 0, F8_MFMA_SCALE, 0, F8_MFMA_SCALE); \
        else { _Pragma("unroll") for (int k = 0; k < 2; ++k) acc[ai][bj][m][n] = __builtin_amdgcn_mfma_f32_16x16x32_bf16(Bt[n][k], At[m][k], acc[ai][bj][m][n], 0, 0, 0); } } \
        __builtin_amdgcn_s_setprio(0); } while (0)
#define PG8_WAIT_V(n) asm volatile("s_waitcnt vmcnt(" #n ")" ::: "memory")
#define PG8_WAIT_L(n) asm volatile("s_waitcnt lgkmcnt(" #n ")" ::: "memory")
#define PG8_BAR __builtin_amdgcn_s_barrier()
#define PG8_SCHED __builtin_amdgcn_sched_barrier(0)
    Unit cur, nxt; int ui = 0;
    if (!S.next(0, cur)) return;
    bool has_next = S.next(1, nxt);
    unsigned vo[2][2], nvo[2][2];
    PG8_LOAD_VO(vo, cur);
    if (has_next) PG8_LOAD_VO(nvo, nxt); else {
#pragma unroll
        for (int h = 0; h < 2; ++h) { nvo[h][0] = vo[h][0]; nvo[h][1] = vo[h][1]; } }
    f32x4 acc[2][2][4][2];
    if constexpr (Epi::ACC_INIT) E.init(acc, cur, wr, wc, fr, fq); else {
#pragma unroll
    for (int a = 0; a < 2; ++a)
#pragma unroll
        for (int b = 0; b < 2; ++b)
#pragma unroll
            for (int m = 0; m < 4; ++m)
#pragma unroll
                for (int n = 0; n < 2; ++n) acc[a][b][m][n] = (f32x4){0.f, 0.f, 0.f, 0.f}; }
    bf16x8 At[4][2], B0[2][2], B1[2][2]; i32x8 At8[4], B08[2], B18[2];
    const char* cB = (const char*)g.Bt + ((size_t)cur.e * (size_t)g.strideE) * 2 + (size_t)cur.pn * tstep;
    PG8_STAGE(PG8_SB(0, 0), cB, voffB); PG8_STAGE(PG8_SB(0, 1), cB + hstep, voffB); PG8_STAGE_A(PG8_SA(0, 0), vo, 0, 0); PG8_STAGE_A(PG8_SA(0, 1), vo, 1, 0);
    if (wr == 1) PG8_BAR;
    PG8_WAIT_V(2); PG8_BAR;
    PG8_STAGE(PG8_SB(1, 0), cB + kstep, voffB); PG8_STAGE_A(PG8_SA(1, 0), vo, 0, kstep); PG8_STAGE(PG8_SB(1, 1), cB + hstep + kstep, voffB);
    PG8_WAIT_V(6); PG8_BAR;
    for (;;) {
        const char* nB = has_next ? (const char*)g.Bt + ((size_t)nxt.e * (size_t)g.strideE) * 2 + (size_t)nxt.pn * tstep : cB;
        for (int t = 0; t < nt; t += 2) {
            const bool last = (t == nt - 2);
            const size_t k1 = (size_t)(t + 1) * kstep, k2 = last ? 0 : (size_t)(t + 2) * kstep, k3 = k2 + kstep;
            const char* b2 = last ? nB : cB + (size_t)(t + 2) * kstep; const char* b3 = b2 + kstep;
            PG8_LDB(B0, 0, 0); PG8_LDB(B1, 0, 1); PG8_SCHED; PG8_LDA(At, 0, 0); PG8_STAGE_A(PG8_SA(1, 1), vo, 1, k1);
            if (last) {
#pragma unroll
                for (int h = 0; h < 2; ++h) { vo[h][0] = nvo[h][0]; vo[h][1] = nvo[h][1]; } }
            PG8_WAIT_V(8); PG8_WAIT_L(0); PG8_BAR; PG8_MMA(0, 0, At, B0); PG8_MMA(0, 1, At, B1); PG8_BAR; PG8_SCHED;
            PG8_LDA(At, 0, 1); PG8_STAGE(PG8_SB(0, 0), b2, voffB); PG8_STAGE(PG8_SB(0, 1), b2 + hstep, voffB); PG8_STAGE_A(PG8_SA(0, 0), vo, 0, k2);
            PG8_WAIT_V(8); PG8_WAIT_L(0); PG8_BAR; PG8_MMA(1, 0, At, B0); PG8_MMA(1, 1, At, B1); PG8_BAR; PG8_SCHED;
            PG8_LDB(B0, 1, 0); PG8_LDB(B1, 1, 1); PG8_SCHED; PG8_LDA(At, 1, 0); PG8_STAGE_A(PG8_SA(0, 1), vo, 1, k2);
            PG8_WAIT_V(8); PG8_WAIT_L(0); PG8_BAR; PG8_MMA(0, 0, At, B0); PG8_MMA(0, 1, At, B1); PG8_BAR; PG8_SCHED;
            PG8_LDA(At, 1, 1); PG8_STAGE(PG8_SB(1, 0), b3, voffB); PG8_STAGE(PG8_SB(1, 1), b3 + hstep, voffB); PG8_STAGE_A(PG8_SA(1, 0), vo, 0, k3);
            PG8_WAIT_V(8); PG8_WAIT_L(0); PG8_BAR; PG8_MMA(1, 0, At, B0); PG8_MMA(1, 1, At, B1); PG8_BAR; PG8_SCHED;
        }
        if (wr == 0) PG8_BAR;
        E(acc, cur, wr, wc, fr, fq);
        if (!has_next) break;
        if constexpr (Epi::ACC_INIT) E.init(acc, nxt, wr, wc, fr, fq); else {
#pragma unroll
        for (int a = 0; a < 2; ++a)
#pragma unroll
            for (int b = 0; b < 2; ++b)
#pragma unroll
                for (int m = 0; m < 4; ++m)
#pragma unroll
                    for (int n = 0; n < 2; ++n) acc[a][b][m][n] = (f32x4){0.f, 0.f, 0.f, 0.f}; }
        cur = nxt; cB = nB; ++ui;
        has_next = S.next(ui + 1, nxt);
        if (has_next) PG8_LOAD_VO(nvo, nxt);
        if (wr == 1) PG8_BAR;
    }
    PG8_WAIT_V(0);
    PG8_BAR;
#undef PG8_SA
#undef PG8_SB
#undef PG8_STAGE
#undef PG8_STAGE_A
#undef PG8_LOAD_VO
#undef PG8_LDA
#undef PG8_LDB
#undef PG8_MMA
#undef PG8_WAIT_V
#undef PG8_WAIT_L
#undef PG8_BAR
#undef PG8_SCHED
}
}

constexpr size_t MiB = 1u << 20;
constexpr size_t WS_CTL = 0, CTL_ZERO_BYTES = 160 * 1024;
constexpr size_t WS_WIN = 1 * MiB;
constexpr size_t WS_WOUT = 25 * MiB;
constexpr size_t WS_WPG = 33 * MiB;
constexpr size_t WS_WPP = 41 * MiB;
constexpr size_t WS_WR = 42 * MiB;
constexpr size_t WS_PB = 43 * MiB;
constexpr size_t WS_XN = 51 * MiB;
constexpr size_t WS_ZB = 115 * MiB;
constexpr size_t WS_MIXB = 307 * MiB;
constexpr size_t WS_X1 = 371 * MiB;
constexpr size_t WS_X1B = 499 * MiB;
constexpr size_t WS_X2 = 563 * MiB;
constexpr size_t WS_X2B = 691 * MiB;
constexpr size_t WS_PLEB = 755 * MiB;
constexpr size_t WS_RSTD = 819 * MiB;
constexpr size_t WS_TOK = 820 * MiB;
constexpr size_t WS_LIST = 821 * MiB;
constexpr size_t WS_HG = 827 * MiB;
constexpr size_t WS_ACT = 1024 * MiB;
constexpr size_t WS_Y = 1312 * MiB;
constexpr size_t WS_WGU = 1600 * MiB;
constexpr size_t WS_WDN = 2112 * MiB;
constexpr size_t WS_END = 2368 * MiB;
constexpr int CW_CNT = 32768, CNT_STRIDE = 64;
constexpr int CW_BAR = 1024;
constexpr int CW_SSQ = 16384;
constexpr int CW_PCNT = 36864;
static_assert(CW_SSQ + T <= CW_CNT && CW_CNT + NE * CNT_STRIDE <= CW_PCNT && (CW_PCNT + 64 * 64) * 4 <= (int)CTL_ZERO_BYTES, "CTL region");

constexpr int RING_OFF = 0, RING_BYTES = 131072;
constexpr int PH_BYTES = 147456;
constexpr int MISC_OFF = PH_BYTES;
constexpr int LDS_BYTES = 163840;
constexpr int MI_BAR = 0;
constexpr int MI_NT = 8;
constexpr int MI_TSTART = 64;
constexpr int MI_TILEE = 128;
constexpr int NWAVES = 8;

#define XB_TMO      128
#define XB_XCNT(j)  (256  + 64 * (j))
#define XB_XSUB(j)  (1280 + 64 * (j))
#define XB_XGEN(j)  (2304 + 64 * (j))
#define XB_TOP      3328
#define XB_TOPGEN   3392
#define XCD_BAR_WORDS 3456
#define XB_SPIN_CAP (1u << 18)
__device__ __forceinline__ unsigned xb_ld(unsigned* p)              { return __hip_atomic_load(p, __ATOMIC_RELAXED, __HIP_MEMORY_SCOPE_AGENT); }
__device__ __forceinline__ unsigned xb_add(unsigned* p, unsigned v) { return __hip_atomic_fetch_add(p, v, __ATOMIC_RELAXED, __HIP_MEMORY_SCOPE_AGENT); }
__device__ __forceinline__ unsigned xb_xcc_id() { return (unsigned)__builtin_amdgcn_s_getreg((3 << 11) | 20) & 0xFu; }
#define XB_SPIN(cond, bar) do { unsigned _sp = 0; while (cond) { __builtin_amdgcn_s_sleep(1); \
    if ((++_sp & 255u) == 0u) { if (xb_ld(&(bar)[XB_TMO])) break; if (_sp > XB_SPIN_CAP) { atomicAdd(&(bar)[XB_TMO], 1u); break; } } } } while (0)
struct XcdBarrier { unsigned* bar; unsigned x; volatile LAS unsigned* st; };
__device__ __forceinline__ XcdBarrier xcd_barrier_post(unsigned* bar, volatile LAS unsigned* st) {
    XcdBarrier b; b.bar = bar; b.x = xb_xcc_id(); b.st = st;
    if (threadIdx.x == 0) (void)xb_add(&bar[XB_XCNT(b.x)], 1u);
    return b;
}
__device__ __forceinline__ void xcd_barrier_complete(unsigned* bar, unsigned x, unsigned& nloc, unsigned& nx) {
    const unsigned G = gridDim.x * gridDim.y * gridDim.z;
    unsigned sum, cnt, mine, sp = 0u;
    for (;;) {
        sum = 0u; cnt = 0u; mine = 0u;
#pragma unroll
        for (unsigned j = 0; j < 16; ++j) { const unsigned c = xb_ld(&bar[XB_XCNT(j)]); sum += c; cnt += (c > 0u) ? 1u : 0u; mine = (j == x) ? c : mine; }
        if (sum == G) break;
        __builtin_amdgcn_s_sleep(1);
        if ((++sp & 255u) == 0u) { if (xb_ld(&bar[XB_TMO])) break; if (sp > XB_SPIN_CAP) { atomicAdd(&bar[XB_TMO], 1u); break; } }
    }
    nloc = mine > 0u ? mine : 1u; nx = cnt > 0u ? cnt : 1u;
}
__device__ __forceinline__ void xcd_barrier(const XcdBarrier& b) {
    asm volatile("s_waitcnt vmcnt(0)" ::: "memory");
    __syncthreads();
    if (threadIdx.x == 0) {
        unsigned* bar = b.bar;
        __builtin_amdgcn_s_waitcnt(0);
        unsigned nloc = b.st[0], nx = b.st[1];
        if (nloc == 0u) { xcd_barrier_complete(bar, b.x, nloc, nx); b.st[0] = nloc; b.st[1] = nx; }
        const unsigned old = xb_add(&bar[XB_XSUB(b.x)], 1u);
        const unsigned gen = old / nloc;
        if (old + 1u == (gen + 1u) * nloc) {
            __builtin_amdgcn_fence(__ATOMIC_RELEASE, "agent");
            asm volatile("s_waitcnt vmcnt(0)" ::: "memory");
            const unsigned og = xb_add(&bar[XB_TOP], 1u);
            const unsigned tg = og / nx;
            if (og + 1u == (tg + 1u) * nx) xb_add(&bar[XB_TOPGEN], 1u);
            else XB_SPIN(xb_ld(&bar[XB_TOPGEN]) == tg, bar);
            __builtin_amdgcn_fence(__ATOMIC_ACQUIRE, "agent");
            xb_add(&bar[XB_XGEN(b.x)], 1u);
            asm volatile("s_waitcnt vmcnt(0)" ::: "memory");
        } else {
            XB_SPIN(xb_ld(&bar[XB_XGEN(b.x)]) == gen, bar);
            __builtin_amdgcn_fence(__ATOMIC_ACQUIRE, "agent");
            asm volatile("s_waitcnt vmcnt(0)" ::: "memory");
        }
    }
    __syncthreads();
}

template <int MAP>
__device__ __forceinline__ void cvt_tile(const float* __restrict__ W, int N, int K, int k0, int n0, bf16_t* __restrict__ WT, const float* __restrict__ kscale, LAS unsigned* scr, int lane) {
    const int kp = lane >> 4, nq = lane & 15;
    f32x4 v[16];
#pragma unroll
    for (int i = 0; i < 8; ++i)
#pragma unroll
        for (int r = 0; r < 2; ++r) v[2 * i + r] = *(const f32x4*)(W + (size_t)(k0 + 8 * i + 2 * kp + r) * N + n0 + 4 * nq);
    if (kscale) {
#pragma unroll
        for (int i = 0; i < 8; ++i)
#pragma unroll
            for (int r = 0; r < 2; ++r) v[2 * i + r] = v[2 * i + r] * kscale[k0 + 8 * i + 2 * kp + r];
    }
#pragma unroll
    for (int i = 0; i < 8; ++i)
#pragma unroll
        for (int j = 0; j < 4; ++j) scr[(4 * nq + j) * 33 + 4 * i + kp] = cvt_pk_bf16(v[2 * i][j], v[2 * i + 1][j]);
    LDS_WAIT();
    const int c = lane & 7;
#pragma unroll
    for (int it = 0; it < 8; ++it) {
        const int nl = (lane >> 3) + 8 * it, n = n0 + nl;
        const LAS unsigned* s = scr + nl * 33 + 4 * c;
        u32x4 o; o.x = s[0]; o.y = s[1]; o.z = s[2]; o.w = s[3];
        int row; if (MAP == 0) row = n; else { const int j = n >> 1; row = 256 * (j >> 7) + 128 * (n & 1) + (j & 127); }
        *(u32x4*)(WT + (size_t)row * K + k0 + 8 * c) = o;
    }
    LDS_WAIT();
}

__device__ __forceinline__ void f8_tile_load(f32x4 (&v)[16], const float* __restrict__ W, int N, int k0, int n0, int lane) {
    const int kp = lane >> 4, nq = lane & 15;
#pragma unroll
    for (int i = 0; i < 4; ++i)
#pragma unroll
        for (int r = 0; r < 4; ++r) v[4 * i + r] = __builtin_nontemporal_load((const f32x4*)(W + (size_t)(k0 + 16 * i + 4 * kp + r) * N + n0 + 4 * nq));
}
template <int MAP>
__device__ __forceinline__ void f8_tile_finish(const f32x4 (&v)[16], const LAS float* ksl, float mul, int K, int k0, int n0, unsigned char* __restrict__ WT, LAS unsigned* scr, int lane) {
    const int kp = lane >> 4, nq = lane & 15;
    f32x4 ks[4];
#pragma unroll
    for (int i = 0; i < 4; ++i) { if (ksl) ks[i] = *(const LAS f32x4*)(ksl + k0 + 16 * i + 4 * kp); else ks[i] = (f32x4){mul, mul, mul, mul}; }
#pragma unroll
    for (int i = 0; i < 4; ++i)
#pragma unroll
        for (int j = 0; j < 4; ++j) scr[(4 * nq + j) * 17 + 4 * i + kp] = pack4_fp8(v[4 * i][j] * ks[i][0], v[4 * i + 1][j] * ks[i][1], v[4 * i + 2][j] * ks[i][2], v[4 * i + 3][j] * ks[i][3]);
    LDS_WAIT();
    const int c = lane & 3;
#pragma unroll
    for (int it = 0; it < 4; ++it) {
        const int nl = (lane >> 2) + 16 * it, n = n0 + nl;
        const LAS unsigned* sp = scr + nl * 17 + 4 * c;
        u32x4 o; o.x = sp[0]; o.y = sp[1]; o.z = sp[2]; o.w = sp[3];
        int row; if (MAP == 0) row = n; else { const int j = n >> 1; row = 256 * (j >> 7) + 128 * (n & 1) + (j & 127); }
        __builtin_nontemporal_store(o, (u32x4*)(WT + (size_t)row * K + k0 + 16 * c));
    }
    LDS_WAIT();
}
template <int MAP>
__device__ __forceinline__ void f8_convert_experts(const float* __restrict__ W, int ne, int K, int N, unsigned char* __restrict__ WT, const LAS float* ksl, float mul, int first, int stride, LAS unsigned* scr, int lane) {
    const int nb = N / 64, per_e = (K / 64) * nb, total = ne * per_e;
    f32x4 va[16], vb[16];
#define F8_LOAD(V, KS, IT) do { const int _e = (IT) / per_e, _q = (IT) % per_e; f8_tile_load(V, W + (size_t)_e * K * N, N, 64 * (_q / nb), 64 * (_q % nb), lane); } while (0)
#define F8_FINISH(V, KS, IT) do { const int _e = (IT) / per_e, _q = (IT) % per_e; f8_tile_finish<MAP>(V, ksl, mul, K, 64 * (_q / nb), 64 * (_q % nb), WT + (size_t)_e * K * N, scr, lane); } while (0)
    int it = first;
    if (it >= total) return;
    F8_LOAD(va, ka, it);
    for (;;) {
        const int itn = it + stride, ln = itn < total ? itn : it;
        F8_LOAD(vb, kb, ln);
        F8_FINISH(va, ka, it);
        if (itn >= total) break;
        const int itm = itn + stride, lm = itm < total ? itm : itn;
        F8_LOAD(va, ka, lm);
        F8_FINISH(vb, kb, itn);
        if (itm >= total) break;
        it = itm;
    }
#undef F8_LOAD
#undef F8_FINISH
}

struct Args { const float* in[22]; float* out; unsigned char* ws; int ph_lo, ph_hi, li, pad; };

__global__ void __launch_bounds__(NWAVES * 64, 2) mk_fwd(Args args) {
    extern __shared__ __attribute__((aligned(16))) unsigned char lds_raw[];
    LAS unsigned char* lds = (LAS unsigned char*)lds_raw;
    volatile LAS unsigned* MISC = (volatile LAS unsigned*)(lds + MISC_OFF);
    const int tid = threadIdx.x, lane = tid & 63, wave = __builtin_amdgcn_readfirstlane(tid >> 6);
    const int G = gridDim.x; const int bx = blockIdx.x; const int vcu = (G % 8 == 0) ? (bx % 8) * (G / 8) + bx / 8 : bx;
    const int gw = vcu * NWAVES + wave, NGW = G * NWAVES;
    unsigned char* ws = args.ws;
    gu32* ctl = (gu32*)(ws + WS_CTL);
    const float* x = args.in[0];
    bf16_t* WinT = (bf16_t*)(ws + WS_WIN); bf16_t* WoutT = (bf16_t*)(ws + WS_WOUT); bf16_t* WpgT = (bf16_t*)(ws + WS_WPG); bf16_t* WppT = (bf16_t*)(ws + WS_WPP);
    bf16_t* WguT = (bf16_t*)(ws + WS_WGU); bf16_t* WdnT = (bf16_t*)(ws + WS_WDN);
    bf16_t* XN = (bf16_t*)(ws + WS_XN); bf16_t* ZB = (bf16_t*)(ws + WS_ZB); bf16_t* MIXB = (bf16_t*)(ws + WS_MIXB); bf16_t* PB = (bf16_t*)(ws + WS_PB);
    bf16_t* X1H = (bf16_t*)(ws + WS_X1); bf16_t* X1L = (bf16_t*)(ws + WS_X1 + 64 * MiB); bf16_t* X1B = (bf16_t*)(ws + WS_X1B);
    for (int u = tid; u < 1024; u += NWAVES * 64) ((LAS unsigned*)(lds + MISC_OFF))[u] = 0u;
    __syncthreads();
    const int lo = args.ph_lo, hi = args.ph_hi;
    XcdBarrier bar; bar.bar = (unsigned*)(ctl + CW_BAR) + args.li * XCD_BAR_WORDS; bar.x = 0; bar.st = nullptr;
    if (hi - lo > 1) bar = xcd_barrier_post((unsigned*)(ctl + CW_BAR) + args.li * XCD_BAR_WORDS, MISC + MI_BAR);
#ifndef NGEMM_SPLIT
#define NGEMM_SPLIT 128
#endif
#ifndef GEMM_ROUNDS
#define GEMM_ROUNDS 11
#endif
#ifndef PHMASK
#define PHMASK 0xfff
#endif
#define IN(k) (((PHMASK >> (k)) & 1) && lo <= (k) && (k) < hi)
#define BOTH(k) (IN(k) && IN((k) + 1))

    constexpr int I_IN = 32 * 96, I_OUT = 32 * 32, I_PG = 32 * 32, I_PP = 4 * 32, I_GU1 = 32 * 64, I_DN1 = 32 * 32;
    constexpr int NITEMS_B = I_OUT + I_PG + I_PP + NE * I_GU1 + NE * I_DN1;
#define PROLOGUE_B(gwb, ngwb) do { \
        LAS unsigned* scr = (LAS unsigned*)(lds + RING_OFF + wave * 16384); \
        EXPERTS_B(gwb, ngwb); \
        for (int it = (gwb); it < I_OUT + I_PG + I_PP; it += (ngwb)) { int r = it; \
            if (r < I_OUT) { if (!OUT_FP8) cvt_tile<0>(args.in[10], D, D, 64 * (r / 32), 64 * (r % 32), WoutT, nullptr, scr, lane); continue; } r -= I_OUT; \
            if (r < I_PG) { if (!MOE_FP8) cvt_tile<0>(args.in[19], D, D, 64 * (r / 32), 64 * (r % 32), WpgT, args.in[18], scr, lane); continue; } r -= I_PG; \
            cvt_tile<0>(args.in[20], D, PLE, 64 * (r / 32), 64 * (r % 32), WppT, nullptr, scr, lane); } \
        for (int m = (gwb); m < T; m += (ngwb)) { const f32x4 v = *((const f32x4*)(args.in[1] + (size_t)m * PLE) + lane); u32x2 w; w.x = cvt_pk_bf16(v[0], v[1]); w.y = cvt_pk_bf16(v[2], v[3]); *((u32x2*)(PB + (size_t)m * PLE) + lane) = w; } \
        { bf16_t* wr_hi = (bf16_t*)(ws + WS_WR); bf16_t* wr_lo = wr_hi + NE * D; \
          for (int i = ((gwb) * 64 + lane); i < NE * D; i += (ngwb) * 64) { const int e = i / D, k = i % D; const float v = args.in[12][(size_t)k * NE + e] * args.in[11][k]; const unsigned short hb = f2bf(v); wr_hi[i] = hb; wr_lo[i] = f2bf(v - bf2f(hb)); } } \
    } while (0)
#if MOE_FP8
#define EXPERTS_B(gwb, ngwb) do { LAS float* sct = (LAS float*)(lds + RING_BYTES);     \
        for (int k = tid; k < D; k += NWAVES * 64) { sct[k] = args.in[11][k] * F8_WSCALE; sct[D + k] = args.in[18][k] * F8_WSCALE; } \
        __syncthreads(); \
        f8_convert_experts<1>(args.in[14], NE, D, 2 * DFF, (unsigned char*)WguT, sct, F8_WSCALE, (gwb), (ngwb), scr, lane); \
        f8_convert_experts<0>(args.in[16], NE, DFF, D, (unsigned char*)WdnT, nullptr, F8_WSCALE, (gwb), (ngwb), scr, lane); \
        f8_convert_experts<0>(args.in[19], 1, D, D, (unsigned char*)WpgT, sct + D, F8_WSCALE, (gwb), (ngwb), scr, lane); \
        if (OUT_FP8) f8_convert_experts<0>(args.in[10], 1, D, D, (unsigned char*)WoutT, nullptr, F8_WSCALE, (gwb), (ngwb), scr, lane); } while (0)
#else
#define EXPERTS_B(gwb, ngwb) do { for (int it = (gwb); it < NE * (I_GU1 + I_DN1); it += (ngwb)) { int r = it; \
            if (r < NE * I_GU1) { const int e = r / I_GU1, q = r % I_GU1; CVT_GU(e, q); continue; } r -= NE * I_GU1; \
            { const int e = r / I_DN1, q = r % I_DN1; CVT_DN(e, q); } } } while (0)
#endif
#if MOE_FP8
#define CVT_GU(e, q) cvt_tile_f8<1>(args.in[14] + (size_t)(e) * D * 2 * DFF, 2 * DFF, D, 64 * ((q) / 64), 64 * ((q) % 64), (unsigned char*)WguT + (size_t)(e) * 2 * DFF * D, args.in[11], F8_WSCALE, scr, lane)
#define CVT_DN(e, q) cvt_tile_f8<0>(args.in[16] + (size_t)(e) * DFF * D, D, DFF, 64 * ((q) / 32), 64 * ((q) % 32), (unsigned char*)WdnT + (size_t)(e) * D * DFF, nullptr, F8_WSCALE, scr, lane)
#else
#define CVT_GU(e, q) cvt_tile<1>(args.in[14] + (size_t)(e) * D * 2 * DFF, 2 * DFF, D, 64 * ((q) / 64), 64 * ((q) % 64), WguT + (size_t)(e) * 2 * DFF * D, args.in[11], scr, lane)
#define CVT_DN(e, q) cvt_tile<0>(args.in[16] + (size_t)(e) * DFF * D, D, DFF, 64 * ((q) / 32), 64 * ((q) % 32), WdnT + (size_t)(e) * D * DFF, nullptr, scr, lane)
#endif
    const int NGEMM = (G == 256) ? NGEMM_SPLIT : G;
    if (IN(0)) {
        LAS unsigned* scr = (LAS unsigned*)(lds + RING_OFF + wave * 16384);
        for (int it = gw; it < I_IN; it += NGW) cvt_tile<0>(args.in[3], IN_W, D, 64 * (it / 96), 64 * (it % 96), WinT, nullptr, scr, lane);
        for (int m = gw; m < T; m += NGW) {
            const f32x4* xr = (const f32x4*)(x + (size_t)m * D) + lane; const f32x4* gr = (const f32x4*)args.in[2] + lane;
            f32x4 v[8]; float s = 0.f;
#pragma unroll
            for (int j = 0; j < 8; ++j) { v[j] = NTLD(4, xr + 64 * j); s += (v[j][0] * v[j][0] + v[j][1] * v[j][1]) + (v[j][2] * v[j][2] + v[j][3] * v[j][3]); }
            const float rr = rsqrtf(wave_sum(s) * (1.f / D) + RMS_EPS);
            u32x2* o8 = (u32x2*)(XN + (size_t)m * D) + lane;
#pragma unroll
            for (int j = 0; j < 8; ++j) { const f32x4 gg = gr[64 * j]; u32x2 w; w.x = cvt_pk_bf16(v[j][0] * rr * gg[0], v[j][1] * rr * gg[1]); w.y = cvt_pk_bf16(v[j][2] * rr * gg[2], v[j][3] * rr * gg[3]); o8[64 * j] = w; }
        }
        if (!IN(1) || NGEMM == G) PROLOGUE_B(gw, NGW);
        if (BOTH(0)) xcd_barrier(bar);
    }
    if (IN(1)) {
        const bool split = (NGEMM != G) && IN(0);
        if (split && bx >= NGEMM) { PROLOGUE_B((bx - NGEMM) * NWAVES + wave, (G - NGEMM) * NWAVES); __syncthreads(); }
        {
            pg8::Gemm g{XN, WinT, nullptr, 0, D, 0}; pg8::StaticOrder S;
            if (!split) S.init(T, IN_W, G, bx); else if (bx < NGEMM) S.init(T, IN_W, NGEMM, bx, 0, GEMM_ROUNDS); else S.init(T, IN_W, G - NGEMM, bx - NGEMM, GEMM_ROUNDS * NGEMM / (G - NGEMM));
            pg8::EpiBf16 E{ZB, IN_W};
            pg8::gemm_phase<pg8::EpiBf16, pg8::StaticOrder, false>(lds + RING_OFF, g, S, E);
        }
        if (BOTH(1)) xcd_barrier(bar);
    }

    if (IN(2)) {
        LAS unsigned char* STb = lds;
        LAS unsigned char* QBl = lds + 34816;
        LAS unsigned char* QRl = lds + 52224;
        LAS unsigned char* KBl = lds + 69632;
        LAS unsigned char* KBLT = lds + 87040;
        LAS unsigned char* VT = lds + 105472;
        LAS unsigned char* PL = lds + 123904;
        LAS float* tot = (LAS float*)(lds + 133120);
        LAS float* dec = (LAS float*)(lds + 135168);
        bf16_t* OL = (bf16_t*)(ws + WS_HG)  ; bf16_t* QBF = (bf16_t*)(ws + WS_HG + 64 * MiB); float* SL = (float*)(ws + WS_HG + 96 * MiB); float* DL = (float*)(ws + WS_HG + 128 * MiB);
        const int d = tid & 127, q = tid >> 7, fr = lane & 15, fq = lane >> 4, tm = wave >> 1, eh = wave & 1;
        for (int unit = bx; unit < BATCH * HG_H * 16; unit += G) {
            const int bh = unit >> 4, sc = unit & 15, b = bh >> 3, h = bh & 7, t_base = b * SEQ + sc * 256;
            const float l0 = args.in[4][h * 128 + d], l1 = args.in[4][HG_K + h * 128 + d]; const float lbv = 1.f / (1.f + expf(l1 - l0));
            f32x4 sacc[8];
#pragma unroll
            for (int i = 0; i < 8; ++i) sacc[i] = (f32x4){0.f, 0.f, 0.f, 0.f};
            float Bcum = 0.f;
            const int rw0 = tid >> 4, rch = tid & 15;
            LAS unsigned char* RAWQ = lds + 34816; LAS unsigned char* RAWF = lds + 51200; LAS unsigned char* RAWV = lds + 67584;
            u32x4 pq[2], pf[2], pv[2];
#pragma unroll
            for (int i = 0; i < 2; ++i) { const bf16_t* zr = ZB + (size_t)(t_base + rw0 + 32 * i) * IN_W + h * 128 + rch * 8; pq[i] = NTLD(3, (const u32x4*)(zr + ZQ)); pf[i] = NTLD(3, (const u32x4*)(zr + ZF)); pv[i] = NTLD(3, (const u32x4*)(zr + ZI)); }
            for (int c = 0; c < 4; ++c) {
                const int tc = t_base + 64 * c;
#pragma unroll
                for (int i = 0; i < 2; ++i) { *(LAS u32x4*)(RAWQ + (rw0 + 32 * i) * 256 + rch * 16) = pq[i]; *(LAS u32x4*)(RAWF + (rw0 + 32 * i) * 256 + rch * 16) = pf[i]; *(LAS u32x4*)(RAWV + (rw0 + 32 * i) * 256 + rch * 16) = pv[i]; }
                __syncthreads();
                unsigned short qr[16], fr_[16], vr[16];
#pragma unroll
                for (int i = 0; i < 16; ++i) { qr[i] = *(const LAS unsigned short*)(RAWQ + (16 * q + i) * 256 + d * 2); fr_[i] = *(const LAS unsigned short*)(RAWF + (16 * q + i) * 256 + d * 2); vr[i] = *(const LAS unsigned short*)(RAWV + (16 * q + i) * 256 + d * 2); }
                float bl[16], qs[16], kk[16]; float run = 0.f;
#pragma unroll
                for (int i = 0; i < 16; ++i) { const float qf = bf2f(qr[i]); qs[i] = qf * fast_sigmoid(qf); const float f = lbv + (1.f - lbv) * fast_sigmoid(bf2f(fr_[i])); kk[i] = 1.f - f; run += fast_log(f); bl[i] = run; }
                tot[q * 128 + d] = run;
                __syncthreads();
                const float t0 = tot[d], t1 = tot[128 + d], t2 = tot[256 + d], t3 = tot[384 + d];
                const float off = (q > 0 ? t0 : 0.f) + (q > 1 ? t1 : 0.f) + (q > 2 ? t2 : 0.f), blast = (t0 + t1) + (t2 + t3), R = 0.5f * blast;
                unsigned kw[8], vw[8];
#pragma unroll
                for (int i = 0; i < 16; i += 2) {
                    float kb2[2];
#pragma unroll
                    for (int j = 0; j < 2; ++j) { const float bb = bl[i + j] + off; const int tt = 16 * q + i + j;
                        const float eb = fast_exp(bb), qbv = qs[i + j] * eb;
                        *(LAS unsigned short*)(QBl + tt * 272 + d * 2) = f2bf(qbv);
                        *(LAS unsigned short*)(QRl + tt * 272 + d * 2) = f2bf(qs[i + j] * fast_exp(bb - R));
                        *(LAS unsigned short*)(KBl + tt * 272 + d * 2) = f2bf(kk[i + j] * fast_exp(R - bb));
                        QBF[(size_t)(tc + tt) * HG_K + h * 128 + d] = f2bf(qs[i + j] * fast_exp(Bcum + bb));
                        kb2[j] = kk[i + j] * fast_exp(blast - bb); }
                    kw[i >> 1] = cvt_pk_bf16(kb2[0], kb2[1]); vw[i >> 1] = (unsigned)vr[i] | ((unsigned)vr[i + 1] << 16);
                }
                *(LAS u32x4*)(KBLT + d * 144 + q * 32) = (u32x4){kw[0], kw[1], kw[2], kw[3]}; *(LAS u32x4*)(KBLT + d * 144 + q * 32 + 16) = (u32x4){kw[4], kw[5], kw[6], kw[7]};
                *(LAS u32x4*)(VT + d * 144 + q * 32) = (u32x4){vw[0], vw[1], vw[2], vw[3]}; *(LAS u32x4*)(VT + d * 144 + q * 32 + 16) = (u32x4){vw[4], vw[5], vw[6], vw[7]};
                if (q == 0) dec[d] = fast_exp(blast);
                Bcum += blast;
                if (c < 3) {
#pragma unroll
                    for (int i = 0; i < 2; ++i) { const bf16_t* zr = ZB + (size_t)(tc + 64 + rw0 + 32 * i) * IN_W + h * 128 + rch * 8; pq[i] = NTLD(3, (const u32x4*)(zr + ZQ)); pf[i] = NTLD(3, (const u32x4*)(zr + ZF)); pv[i] = NTLD(3, (const u32x4*)(zr + ZI)); } }
                __syncthreads();
#pragma unroll
                for (int si = 0; si < 2; ++si) { const int ts = 2 * eh + si; u32x2 pw = (u32x2){0u, 0u};
                    if (ts <= tm) { f32x4 a4 = (f32x4){0.f, 0.f, 0.f, 0.f};
#pragma unroll
                        for (int ks = 0; ks < 4; ++ks) { const bf16x8 af = *(const LAS bf16x8*)(KBl + (ts * 16 + fr) * 272 + (32 * ks + 8 * fq) * 2), bfv = *(const LAS bf16x8*)(QRl + (tm * 16 + fr) * 272 + (32 * ks + 8 * fq) * 2);
                            a4 = __builtin_amdgcn_mfma_f32_16x16x32_bf16(af, bfv, a4, 0, 0, 0); }
                        const int tt = tm * 16 + fr, s0 = ts * 16 + 4 * fq;
                        pw.x = cvt_pk_bf16(s0 + 0 <= tt ? a4[0] : 0.f, s0 + 1 <= tt ? a4[1] : 0.f); pw.y = cvt_pk_bf16(s0 + 2 <= tt ? a4[2] : 0.f, s0 + 3 <= tt ? a4[3] : 0.f); }
                    *(LAS u32x2*)(PL + (tm * 16 + fr) * 144 + (ts * 16 + 4 * fq) * 2) = pw; }
                f32x4 oacc[4];
#pragma unroll
                for (int et = 0; et < 4; ++et) oacc[et] = (f32x4){0.f, 0.f, 0.f, 0.f};
                if (c > 0) {
#pragma unroll
                    for (int ks = 0; ks < 4; ++ks) { const bf16x8 bfv = *(const LAS bf16x8*)(QBl + (tm * 16 + fr) * 272 + (32 * ks + 8 * fq) * 2);
#pragma unroll
                        for (int et = 0; et < 4; ++et) { const bf16x8 af = *(const LAS bf16x8*)(STb + ((4 * eh + et) * 16 + fr) * 272 + (32 * ks + 8 * fq) * 2);
                            oacc[et] = __builtin_amdgcn_mfma_f32_16x16x32_bf16(af, bfv, oacc[et], 0, 0, 0); } }
                }
                __syncthreads();
#pragma unroll
                for (int ks = 0; ks < 2; ++ks) if (32 * ks <= 16 * tm + 15) { const bf16x8 bfv = *(const LAS bf16x8*)(PL + (tm * 16 + fr) * 144 + (32 * ks + 8 * fq) * 2);
#pragma unroll
                    for (int et = 0; et < 4; ++et) { const bf16x8 af = *(const LAS bf16x8*)(VT + ((4 * eh + et) * 16 + fr) * 144 + (32 * ks + 8 * fq) * 2);
                        oacc[et] = __builtin_amdgcn_mfma_f32_16x16x32_bf16(af, bfv, oacc[et], 0, 0, 0); } }
#pragma unroll
                for (int et = 0; et < 4; ++et) { u32x2 w; w.x = cvt_pk_bf16(oacc[et][0], oacc[et][1]); w.y = cvt_pk_bf16(oacc[et][2], oacc[et][3]); *(u32x2*)(OL + (size_t)(tc + tm * 16 + fr) * HG_V + h * 128 + (4 * eh + et) * 16 + 4 * fq) = w; }
#pragma unroll
                for (int dt = 0; dt < 8; ++dt) { const f32x4 dv = *(const LAS f32x4*)(dec + 16 * dt + 4 * fq); sacc[dt] = sacc[dt] * dv;
#pragma unroll
                    for (int ks = 0; ks < 2; ++ks) { const bf16x8 af = *(const LAS bf16x8*)(KBLT + (dt * 16 + fr) * 144 + (32 * ks + 8 * fq) * 2), bfv = *(const LAS bf16x8*)(VT + (wave * 16 + fr) * 144 + (32 * ks + 8 * fq) * 2);
                        sacc[dt] = __builtin_amdgcn_mfma_f32_16x16x32_bf16(af, bfv, sacc[dt], 0, 0, 0); }
                    if (c < 3) { u32x2 w; w.x = cvt_pk_bf16(sacc[dt][0], sacc[dt][1]); w.y = cvt_pk_bf16(sacc[dt][2], sacc[dt][3]); *(LAS u32x2*)(STb + (wave * 16 + fr) * 272 + (16 * dt + 4 * fq) * 2) = w; } }
            }
#pragma unroll
            for (int dt = 0; dt < 8; ++dt) *(f32x4*)(SL + (size_t)unit * 16384 + (wave * 16 + fr) * 128 + 16 * dt + 4 * fq) = sacc[dt];
            if (q == 0) DL[unit * 128 + d] = fast_exp(Bcum);
            __syncthreads();
        }
        { float* stats = (float*)(ws + WS_HG + 145 * MiB);
          for (int t = gw; t < T; t += NGW) {
            const u32x4 w0 = *(const u32x4*)(ZB + (size_t)t * IN_W + ZV + 16 * lane), w1 = *(const u32x4*)(ZB + (size_t)t * IN_W + ZV + 16 * lane + 8);
            float v[16] = {bflo(w0.x), bfhi(w0.x), bflo(w0.y), bfhi(w0.y), bflo(w0.z), bfhi(w0.z), bflo(w0.w), bfhi(w0.w), bflo(w1.x), bfhi(w1.x), bflo(w1.y), bfhi(w1.y), bflo(w1.z), bfhi(w1.z), bflo(w1.w), bfhi(w1.w)};
            float sm = 0.f;
#pragma unroll
            for (int j = 0; j < 16; ++j) { v[j] = gelu_fast(v[j]); sm += v[j]; }
            const float mu = wave_sum(sm) * (1.f / GM_W); float qq = 0.f;
#pragma unroll
            for (int j = 0; j < 16; ++j) { const float dd = v[j] - mu; qq += dd * dd; }
            const float rs = rsqrtf(wave_sum(qq) * (1.f / GM_W) + LN_EPS);
            if (lane == 0) { stats[2 * t] = mu; stats[2 * t + 1] = rs; } } }
        if (BOTH(2)) xcd_barrier(bar);
    }
    if (IN(3)) {
        const float* SL = (const float*)(ws + WS_HG + 96 * MiB); const float* DL = (const float*)(ws + WS_HG + 128 * MiB); bf16_t* SINb = (bf16_t*)(ws + WS_HG + 129 * MiB);
        for (int item = bx; item < BATCH * HG_H * 8; item += G) {
            const int bh = item >> 3, sl = item & 7; const int eo = sl * 2048 + tid * 4;
            f32x4 st = (f32x4){0.f, 0.f, 0.f, 0.f};
#pragma unroll
            for (int sc = 0; sc < 15; ++sc) { const int unit = bh * 16 + sc;
                const f32x4 sl4 = *(const f32x4*)(SL + (size_t)unit * 16384 + eo), dv = *(const f32x4*)(DL + unit * 128 + (eo & 127));
                st = st * dv + sl4;
                u32x2 w; w.x = cvt_pk_bf16(st[0], st[1]); w.y = cvt_pk_bf16(st[2], st[3]); *(u32x2*)(SINb + (size_t)(unit + 1) * 16384 + eo) = w; }
        }
        if (BOTH(3)) xcd_barrier(bar);
    }
    if (IN(4)) {
        const bf16_t* OL = (const bf16_t*)(ws + WS_HG); const bf16_t* QBF = (const bf16_t*)(ws + WS_HG + 64 * MiB); const bf16_t* SINb = (const bf16_t*)(ws + WS_HG + 129 * MiB);
        const int fr = lane & 15, fq = lane >> 4;
        for (int unit = bx; unit < BATCH * HG_H * 32; unit += G) {
            const int bh = unit >> 5, blk = unit & 31, b = bh >> 3, h = bh & 7, sc = blk >> 1;
            const int t = b * SEQ + blk * 128 + wave * 16 + fr;
            f32x4 acc[8]; u32x2 ogv[8];
#pragma unroll
            for (int et = 0; et < 8; ++et) { const u32x2 ow = NTLD(2, (const u32x2*)(OL + (size_t)t * HG_V + h * 128 + et * 16 + 4 * fq)); acc[et] = (f32x4){bflo(ow.x), bfhi(ow.x), bflo(ow.y), bfhi(ow.y)}; ogv[et] = NTLD(2, (const u32x2*)(ZB + (size_t)t * IN_W + ZG + h * 128 + et * 16 + 4 * fq)); }
            if (sc > 0) { const bf16_t* Sp = SINb + (size_t)(bh * 16 + sc) * 16384;
#pragma unroll
                for (int ks = 0; ks < 4; ++ks) { const bf16x8 bfv = NTLD(2, (const bf16x8*)(QBF + (size_t)t * HG_K + h * 128 + 32 * ks + 8 * fq));
#pragma unroll
                    for (int et = 0; et < 8; ++et) { const bf16x8 af = *(const bf16x8*)(Sp + (et * 16 + fr) * 128 + 32 * ks + 8 * fq);
                        acc[et] = __builtin_amdgcn_mfma_f32_16x16x32_bf16(af, bfv, acc[et], 0, 0, 0); } } }
            float ss = 0.f;
#pragma unroll
            for (int et = 0; et < 8; ++et) ss += (acc[et][0] * acc[et][0] + acc[et][1] * acc[et][1]) + (acc[et][2] * acc[et][2] + acc[et][3] * acc[et][3]);
            ss += __shfl_xor(ss, 16); ss += __shfl_xor(ss, 32);
            const float rr = rsqrtf(ss * (1.f / 128.f) + RMS_EPS);
#pragma unroll
            for (int et = 0; et < 8; ++et) { const int e0 = h * 128 + et * 16 + 4 * fq;
                const f32x4 gn = *(const f32x4*)(args.in[5] + e0); const u32x2 og = ogv[et];
                const float m0 = acc[et][0] * rr * gn[0] * fast_sigmoid(bflo(og.x)), m1 = acc[et][1] * rr * gn[1] * fast_sigmoid(bfhi(og.x)), m2 = acc[et][2] * rr * gn[2] * fast_sigmoid(bflo(og.y)), m3 = acc[et][3] * rr * gn[3] * fast_sigmoid(bfhi(og.y));
#if OUT_FP8
                *(unsigned*)((unsigned char*)MIXB + (size_t)t * D + e0) = pack4_fp8c(m0 * F8_MSCALE, m1 * F8_MSCALE, m2 * F8_MSCALE, m3 * F8_MSCALE); }
#else
                u32x2 w; w.x = cvt_pk_bf16(m0, m1); w.y = cvt_pk_bf16(m2, m3);
                *(u32x2*)(MIXB + (size_t)t * D + e0) = w; }
#endif
        }
        {
            LAS unsigned char* VNT = lds;
            LAS unsigned char* WL = lds + 34816;
            const float* stats = (const float*)(ws + WS_HG + 145 * MiB);
            __syncthreads();
            for (int unit = bx; unit < BATCH * 32 * GM_G; unit += G) {
                const int g = unit & 7, tb = (unit >> 3) * 128;
                LAS float* sst = (LAS float*)(lds + 69632);
                const int c8 = tid & 15, sr = tid >> 4, tw = tid >> 2, seg = tid & 3;
                u32x4 vraw[4];
#pragma unroll
                for (int i = 0; i < 4; ++i) vraw[i] = NTLD(2, (const u32x4*)(ZB + (size_t)(tb + 4 * sr + i) * IN_W + ZV + g * 128 + 8 * c8));
                f32x4 w4[8]; { const float* wp = args.in[8] + ((size_t)g * 128 + tw) * 128 + 32 * seg;
#pragma unroll
                  for (int j = 0; j < 8; ++j) w4[j] = *(const f32x4*)(wp + 4 * j); }
                u32x2 uw[8];
#pragma unroll
                for (int ct = 0; ct < 8; ++ct) uw[ct] = NTLD(2, (const u32x2*)(ZB + (size_t)(tb + 16 * wave + fr) * IN_W + ZU + g * 128 + 16 * ct + 4 * fq));
                const f32x4 lg0 = *(const f32x4*)(args.in[6] + g * 128 + 8 * c8), lg1 = *(const f32x4*)(args.in[6] + g * 128 + 8 * c8 + 4), lb0 = *(const f32x4*)(args.in[7] + g * 128 + 8 * c8), lb1 = *(const f32x4*)(args.in[7] + g * 128 + 8 * c8 + 4);
                if (tid < 256) sst[tid] = ld_agent_f(stats + 2 * tb + tid);
                __syncthreads();
                { const float lgv[8] = {lg0[0], lg0[1], lg0[2], lg0[3], lg1[0], lg1[1], lg1[2], lg1[3]}, lbv8[8] = {lb0[0], lb0[1], lb0[2], lb0[3], lb1[0], lb1[1], lb1[2], lb1[3]};
                  float vn4[4][8];
#pragma unroll
                  for (int i = 0; i < 4; ++i) { const f32x2 st = *(const LAS f32x2*)(sst + 2 * (4 * sr + i)); const u32x4 w = vraw[i];
                      const float rv[8] = {bflo(w.x), bfhi(w.x), bflo(w.y), bfhi(w.y), bflo(w.z), bfhi(w.z), bflo(w.w), bfhi(w.w)};
#pragma unroll
                      for (int j = 0; j < 8; ++j) vn4[i][j] = (gelu_fast(rv[j]) - st[0]) * st[1] * lgv[j] + lbv8[j]; }
#pragma unroll
                  for (int j = 0; j < 8; ++j) { u32x2 w; w.x = cvt_pk_bf16(vn4[0][j], vn4[1][j]); w.y = cvt_pk_bf16(vn4[2][j], vn4[3][j]); *(LAS u32x2*)(VNT + (8 * c8 + j) * 272 + 8 * sr) = w; } }
                { unsigned pk[16];
#pragma unroll
                  for (int j = 0; j < 8; ++j) { const int s0 = 32 * seg + 4 * j;
                      pk[2 * j] = cvt_pk_bf16(s0 <= tw ? w4[j][0] : 0.f, s0 + 1 <= tw ? w4[j][1] : 0.f); pk[2 * j + 1] = cvt_pk_bf16(s0 + 2 <= tw ? w4[j][2] : 0.f, s0 + 3 <= tw ? w4[j][3] : 0.f); }
#pragma unroll
                  for (int j = 0; j < 4; ++j) *(LAS u32x4*)(WL + tw * 272 + seg * 64 + j * 16) = (u32x4){pk[4 * j], pk[4 * j + 1], pk[4 * j + 2], pk[4 * j + 3]}; }
                __syncthreads();
                f32x4 acc[8];
#pragma unroll
                for (int ct = 0; ct < 8; ++ct) acc[ct] = (f32x4){0.f, 0.f, 0.f, 0.f};
                for (int ks = 0; ks <= (16 * wave + 15) >> 5; ++ks) { const bf16x8 bfv = *(const LAS bf16x8*)(WL + (16 * wave + fr) * 272 + (32 * ks + 8 * fq) * 2);
#pragma unroll
                    for (int ct = 0; ct < 8; ++ct) { const bf16x8 af = *(const LAS bf16x8*)(VNT + (16 * ct + fr) * 272 + (32 * ks + 8 * fq) * 2);
                        acc[ct] = __builtin_amdgcn_mfma_f32_16x16x32_bf16(af, bfv, acc[ct], 0, 0, 0); } }
                const int t = tb + 16 * wave + fr; const float bsv = args.in[9][g * 128 + 16 * wave + fr];
#pragma unroll
                for (int ct = 0; ct < 8; ++ct) { const int c0 = g * 128 + 16 * ct + 4 * fq;
                    const float m0 = gelu_fast(bflo(uw[ct].x)) * (acc[ct][0] + bsv), m1 = gelu_fast(bfhi(uw[ct].x)) * (acc[ct][1] + bsv), m2 = gelu_fast(bflo(uw[ct].y)) * (acc[ct][2] + bsv), m3 = gelu_fast(bfhi(uw[ct].y)) * (acc[ct][3] + bsv);
#if OUT_FP8
                    *(unsigned*)((unsigned char*)MIXB + (size_t)t * D + 1024 + c0) = pack4_fp8c(m0 * F8_MSCALE, m1 * F8_MSCALE, m2 * F8_MSCALE, m3 * F8_MSCALE); }
#else
                    u32x2 w; w.x = cvt_pk_bf16(m0, m1); w.y = cvt_pk_bf16(m2, m3);
                    *(u32x2*)(MIXB + (size_t)t * D + 1024 + c0) = w; }
#endif
                __syncthreads();
            }
        }
        if (BOTH(4)) xcd_barrier(bar);
    }
    if (IN(5)) {
        pg8::Gemm g{MIXB, WoutT, nullptr, 0, D / (OUT_FP8 ? 2 : 1), 0}; pg8::StaticOrder S; S.init(T, D, G, bx);
        pg8::EpiResF32Bf16 E{x, X1H, X1L, X1B};
        pg8::gemm_phase<pg8::EpiResF32Bf16, pg8::StaticOrder, false, OUT_FP8 != 0>(lds + RING_OFF, g, S, E);
        if (BOTH(5)) xcd_barrier(bar);
    }

    if (IN(6)) {
        typedef float f32x16 __attribute__((ext_vector_type(16)));
        const bf16_t* wr_hi = (const bf16_t*)(ws + WS_WR); const bf16_t* wr_lo = wr_hi + NE * D;
        int* cntg = (int*)(ctl + CW_CNT);
        int* list = (int*)(ws + WS_LIST); float* rsl = (float*)(ws + WS_LIST + 2 * MiB); float* gtl = (float*)(ws + WS_LIST + 4 * MiB);
        int* tok_e = (int*)(ws + WS_TOK); int* tok_p = tok_e + T * 4; float* tok_g = (float*)(tok_p + T * 4);
        LAS float* part = (LAS float*)(lds + RING_OFF);
        LAS float* ssqp = (LAS float*)(lds + RING_OFF + 36864);
        LAS float* lgt = (LAS float*)(lds + RING_OFF + 40960);
        LAS int* hist = (LAS int*)(lds + RING_OFF + 53248);
        const int tg = wave >> 2, kq = wave & 3, r = lane & 31, h = lane >> 5;
        for (int grp = bx; grp < T / 64; grp += G) {
            const int t0 = grp * 64;
            if (tid < 64) hist[tid] = 0;
            f32x16 acc;
#pragma unroll
            for (int i = 0; i < 16; ++i) acc[i] = 0.f;
            const bf16_t* xhp = X1H + (size_t)(t0 + tg * 32 + r) * D + kq * 512 + 8 * h; const bf16_t* xlp = X1L + (size_t)(t0 + tg * 32 + r) * D + kq * 512 + 8 * h;
            const bf16_t* whp = wr_hi + (size_t)r * D + kq * 512 + 8 * h; const bf16_t* wlp = wr_lo + (size_t)r * D + kq * 512 + 8 * h;
            float ss = 0.f;
#pragma unroll 8
            for (int s = 0; s < 32; ++s) {
                const bf16x8 xh = *(const bf16x8*)(xhp + 16 * s); bf16x8 xl = xh; if (X1_LO) xl = *(const bf16x8*)(xlp + 16 * s);
                const bf16x8 wh = *(const bf16x8*)(whp + 16 * s), wl = *(const bf16x8*)(wlp + 16 * s);
#pragma unroll
                for (int j = 0; j < 8; ++j) { const float xv = bf2f((unsigned short)xh[j]) + (X1_LO ? bf2f((unsigned short)xl[j]) : 0.f); ss += xv * xv; }
                acc = __builtin_amdgcn_mfma_f32_32x32x16_bf16(wh, xh, acc, 0, 0, 0);
                if (X1_LO) acc = __builtin_amdgcn_mfma_f32_32x32x16_bf16(wh, xl, acc, 0, 0, 0);
                acc = __builtin_amdgcn_mfma_f32_32x32x16_bf16(wl, xh, acc, 0, 0, 0);
            }
            ss += __shfl_xor(ss, 32);
            if (h == 0) ssqp[(tg * 4 + kq) * 32 + r] = ss;
#pragma unroll
            for (int i = 0; i < 16; ++i) part[((tg * 4 + kq) * 32 + r) * 33 + (i & 3) + 8 * (i >> 2) + 4 * h] = acc[i];
            __syncthreads();
            {
                const int tk = lane, tgg = tk >> 5, rr = tk & 31;
                const float sq = ssqp[(tgg * 4 + 0) * 32 + rr] + ssqp[(tgg * 4 + 1) * 32 + rr] + ssqp[(tgg * 4 + 2) * 32 + rr] + ssqp[(tgg * 4 + 3) * 32 + rr];
                const float rstd = rsqrtf(sq * (1.f / D) + RMS_EPS);
#pragma unroll
                for (int j = 0; j < 4; ++j) { const int e = wave * 4 + j;
                    const float v = part[((tgg * 4 + 0) * 32 + rr) * 33 + e] + part[((tgg * 4 + 1) * 32 + rr) * 33 + e] + part[((tgg * 4 + 2) * 32 + rr) * 33 + e] + part[((tgg * 4 + 3) * 32 + rr) * 33 + e];
                    lgt[tk * 33 + e] = v * rstd + args.in[13][e]; }
                if (wave == 0) lgt[tk * 33 + 32] = rstd;
            }
            __syncthreads();
            if (wave == 0) {
                const int t = t0 + lane;
                float lv[32];
#pragma unroll
                for (int e = 0; e < 32; ++e) lv[e] = lgt[lane * 33 + e];
                const float rstd = lgt[lane * 33 + 32];
                float tv[4]; int ti[4];
#pragma unroll
                for (int k = 0; k < 4; ++k) { float bv = lv[0]; int bi = 0;
#pragma unroll
                    for (int e = 1; e < 32; ++e) if (lv[e] > bv) { bv = lv[e]; bi = e; }
                    tv[k] = bv; ti[k] = bi;
#pragma unroll
                    for (int e = 0; e < 32; ++e) if (e == bi) lv[e] = -INFINITY; }
                const float e1 = expf(tv[1] - tv[0]), e2 = expf(tv[2] - tv[0]), e3 = expf(tv[3] - tv[0]); const float inv = 1.f / (1.f + e1 + e2 + e3);
                const float gk[4] = {inv, e1 * inv, e2 * inv, e3 * inv};
                int rk[4];
#pragma unroll
                for (int k = 0; k < 4; ++k) rk[k] = __hip_atomic_fetch_add(hist + ti[k], 1, __ATOMIC_RELAXED, __HIP_MEMORY_SCOPE_WORKGROUP);
                LDS_WAIT();
                if (lane < 32) { const int c = hist[lane]; hist[32 + lane] = c > 0 ? atomicAdd(cntg + lane * CNT_STRIDE, c) : 0; }
                LDS_WAIT();
#pragma unroll
                for (int k = 0; k < 4; ++k) { const int e = ti[k], ps = hist[32 + e] + rk[k];
                    list[e * LISTCAP + ps] = t; rsl[e * LISTCAP + ps] = rstd; gtl[e * LISTCAP + ps] = gk[k];
                    tok_e[t * 4 + k] = e; tok_p[t * 4 + k] = ps; tok_g[t * 4 + k] = gk[k]; }
            }
            __syncthreads();
        }
        if (BOTH(6)) xcd_barrier(bar);
    }
#define BUILD_TILE_TABLE() do { \
        if (wave == 0) { const int c = lane < NE ? ((const int*)(ctl + CW_CNT))[lane * CNT_STRIDE] : 0; int nt = (c + 255) >> 8, inc = nt; \
            _Pragma("unroll") for (int o = 1; o < 64; o <<= 1) { const int v = __shfl_up(inc, o); if (lane >= o) inc += v; } \
            if (lane < NE) MISC[MI_TSTART + lane] = (unsigned)(inc - nt); if (lane == NE - 1) { MISC[MI_TSTART + NE] = (unsigned)inc; MISC[MI_NT] = (unsigned)inc; } } \
        __syncthreads(); \
        { const int NTt = (int)MISC[MI_NT]; if (tid < NTt) { int e = 0; _Pragma("unroll") for (int q = 1; q < NE; ++q) e += ((int)MISC[MI_TSTART + q] <= tid) ? 1 : 0; MISC[MI_TILEE + tid] = (unsigned)e; } } \
        __syncthreads(); } while (0)
    if (IN(7)) {
        BUILD_TILE_TABLE();
        pg8::Gemm g{X1B, WguT, (const int*)(ws + WS_LIST), (long long)2 * DFF * D / (MOE_FP8 ? 2 : 1), D / (MOE_FP8 ? 2 : 1), T - 1};
        pg8::MoeOrder S{(int)MISC[MI_NT], 2 * DFF / 256, G, bx, (const LAS int*)(lds + MISC_OFF) + MI_TILEE, (const LAS int*)(lds + MISC_OFF) + MI_TSTART};
        pg8::EpiSwiglu E{(bf16_t*)(ws + WS_ACT), (const float*)(ws + WS_LIST + 2 * MiB), args.in[15]};
        pg8::gemm_phase<pg8::EpiSwiglu, pg8::MoeOrder, true, MOE_FP8 != 0>(lds + RING_OFF, g, S, E);
        if (BOTH(7)) xcd_barrier(bar);
    }
    if (IN(8)) {
        BUILD_TILE_TABLE();
        pg8::Gemm g{(const bf16_t*)(ws + WS_ACT), WdnT, nullptr, (long long)D * DFF / (MOE_FP8 ? 2 : 1), DFF / (MOE_FP8 ? 2 : 1), 0};
        pg8::MoeOrder S{(int)MISC[MI_NT], D / 256, G, bx, (const LAS int*)(lds + MISC_OFF) + MI_TILEE, (const LAS int*)(lds + MISC_OFF) + MI_TSTART};
        pg8::EpiDown E{(bf16_t*)(ws + WS_Y), (const float*)(ws + WS_LIST + 4 * MiB), args.in[17]};
        pg8::gemm_phase<pg8::EpiDown, pg8::MoeOrder, false, MOE_FP8 != 0>(lds + RING_OFF, g, S, E);
        if (BOTH(8)) xcd_barrier(bar);
    }
    if (IN(9)) {
        BUILD_TILE_TABLE();
        const int* tok_e = (const int*)(ws + WS_TOK); const int* tok_p = tok_e + T * 4;
        bf16_t* X2B = (bf16_t*)(ws + WS_X2B); unsigned char* X2F8 = (unsigned char*)(ws + WS_X2); float* rstd2 = (float*)(ws + WS_RSTD);
        for (int tb0 = gw; tb0 < T; tb0 += 8 * NGW) {
          int myrow = 0; { const int tt = tb0 + (lane >> 2) * NGW; if (lane < 32 && tt < T) { const int e = tok_e[tt * 4 + (lane & 3)]; myrow = (int)MISC[MI_TSTART + e] * 256 + tok_p[tt * 4 + (lane & 3)]; } }
#pragma unroll 2
          for (int ti = 0; ti < 8; ++ti) { const int t = tb0 + ti * NGW; if (t >= T) break;
            int rowk[4];
#pragma unroll
            for (int k = 0; k < 4; ++k) rowk[k] = __shfl(myrow, ti * 4 + k);
            float s = 0.f;
#pragma unroll
            for (int j = 0; j < 4; ++j) {
                const size_t c = (size_t)8 * lane + 512 * j;
                const u32x4 ah = __builtin_nontemporal_load((const u32x4*)(X1H + (size_t)t * D + c)); u32x4 al = (u32x4){0u, 0u, 0u, 0u}; if (X1_LO) al = *(const u32x4*)(X1L + (size_t)t * D + c);
                float v[8] = {bflo(ah.x) + bflo(al.x), bfhi(ah.x) + bfhi(al.x), bflo(ah.y) + bflo(al.y), bfhi(ah.y) + bfhi(al.y), bflo(ah.z) + bflo(al.z), bfhi(ah.z) + bfhi(al.z), bflo(ah.w) + bflo(al.w), bfhi(ah.w) + bfhi(al.w)};
#if MOE_FP8
                float ys[8] = {0.f, 0.f, 0.f, 0.f, 0.f, 0.f, 0.f, 0.f};
#pragma unroll
                for (int k = 0; k < 4; ++k) { const u32x2 y = __builtin_nontemporal_load((const u32x2*)((const unsigned char*)(ws + WS_Y) + (size_t)rowk[k] * D + c)); float lo[4], hi[4]; unpack4_fp8(y.x, lo); unpack4_fp8(y.y, hi);
#pragma unroll
                    for (int i = 0; i < 4; ++i) { ys[i] += lo[i]; ys[4 + i] += hi[i]; } }
#pragma unroll
                for (int i = 0; i < 8; ++i) v[i] += ys[i] * (1.f / F8_YSCALE);
#else
#pragma unroll
                for (int k = 0; k < 4; ++k) { const u32x4 y = *(const u32x4*)((const bf16_t*)(ws + WS_Y) + (size_t)rowk[k] * D + c);
                    v[0] += bflo(y.x); v[1] += bfhi(y.x); v[2] += bflo(y.y); v[3] += bfhi(y.y); v[4] += bflo(y.z); v[5] += bfhi(y.z); v[6] += bflo(y.w); v[7] += bfhi(y.w); }
#endif
                u32x4 w; w.x = cvt_pk_bf16(v[0], v[1]); w.y = cvt_pk_bf16(v[2], v[3]); w.z = cvt_pk_bf16(v[4], v[5]); w.w = cvt_pk_bf16(v[6], v[7]);
                *(u32x4*)(X2B + (size_t)t * D + c) = w;
#if MOE_FP8
                u32x2 w8; w8.x = pack4_fp8c(v[0] * F8_XSCALE, v[1] * F8_XSCALE, v[2] * F8_XSCALE, v[3] * F8_XSCALE); w8.y = pack4_fp8c(v[4] * F8_XSCALE, v[5] * F8_XSCALE, v[6] * F8_XSCALE, v[7] * F8_XSCALE);
                *(u32x2*)(X2F8 + (size_t)t * D + c) = w8;
#endif
#pragma unroll
                for (int i = 0; i < 8; ++i) s += v[i] * v[i];
            }
            s = wave_sum(s);
            if (lane == 0) rstd2[t] = rsqrtf(s * (1.f / D) + RMS_EPS);
          }
        }
        __syncthreads();
        pg8::Gemm g{PB, WppT, nullptr, 0, PLE, 0}; pg8::StaticOrder S; S.init(T, D, G, bx);
        pg8::EpiBf16 E{(bf16_t*)(ws + WS_PLEB), D};
        pg8::gemm_phase<pg8::EpiBf16, pg8::StaticOrder, false>(lds + RING_OFF, g, S, E);
        if (BOTH(9)) xcd_barrier(bar);
    }
    if (IN(10)) {
        pg8::Gemm g{MOE_FP8 ? (const bf16_t*)(ws + WS_X2) : (const bf16_t*)(ws + WS_X2B), WpgT, nullptr, 0, D / (MOE_FP8 ? 2 : 1), 0};
        if (G == 256) {
            pg8::StaticOrder S; S.init(T, D, G, bx, 0, 1 << 30, 4);
            pg8::EpiPleGateNorm E{(const bf16_t*)(ws + WS_X2B), (const float*)(ws + WS_RSTD), (const bf16_t*)(ws + WS_PLEB), args.out, (float*)(ctl + CW_SSQ), (unsigned*)(ctl + CW_PCNT), args.in[21]};
            pg8::gemm_phase<pg8::EpiPleGateNorm, pg8::StaticOrder, false, MOE_FP8 != 0>(lds + RING_OFF, g, S, E);
        } else {
            pg8::StaticOrder S; S.init(T, D, G, bx);
            pg8::EpiPleGate E{(const bf16_t*)(ws + WS_X2B), (const float*)(ws + WS_RSTD), (const bf16_t*)(ws + WS_PLEB), XN  , (float*)(ctl + CW_SSQ)};
            pg8::gemm_phase<pg8::EpiPleGate, pg8::StaticOrder, false, MOE_FP8 != 0>(lds + RING_OFF, g, S, E);
            if (BOTH(10)) xcd_barrier(bar);
        }
    }
    if (IN(11) && G != 256) {
        const float* ssq = (const float*)(ctl + CW_SSQ);
        for (int m = gw; m < T; m += NGW) {
            const float rr = rsqrtf(ld_agent_f(ssq + m) * (1.f / D) + RMS_EPS);
#pragma unroll
            for (int j = 0; j < 4; ++j) { const size_t c = (size_t)8 * lane + 512 * j; const u32x4 xw = *(const u32x4*)(XN + (size_t)m * D + c);
                const f32x4 g0 = *(const f32x4*)(args.in[21] + c), g1 = *(const f32x4*)(args.in[21] + c + 4);
                f32x4 o0, o1; o0[0] = bflo(xw.x) * rr * g0[0]; o0[1] = bfhi(xw.x) * rr * g0[1]; o0[2] = bflo(xw.y) * rr * g0[2]; o0[3] = bfhi(xw.y) * rr * g0[3];
                o1[0] = bflo(xw.z) * rr * g1[0]; o1[1] = bfhi(xw.z) * rr * g1[1]; o1[2] = bflo(xw.w) * rr * g1[2]; o1[3] = bfhi(xw.w) * rr * g1[3];
                *(f32x4*)(args.out + (size_t)m * D + c) = o0; *(f32x4*)(args.out + (size_t)m * D + c + 4) = o1; }
        }
    }
#undef IN
#undef BOTH
}

static int g_grid = 0;
static void mk(hipStream_t st, const Args& base, int lo, int hi, int li = 0) {
    Args a = base; a.ph_lo = lo; a.ph_hi = hi; a.li = li;
    hipLaunchKernelGGL(mk_fwd, dim3(g_grid), dim3(NWAVES * 64), LDS_BYTES, st, a);
}

extern "C" void kernel_launch(void* const* d_in, const int* in_sizes, int n_in, void* d_out, int out_size, void* d_ws, size_t ws_size, hipStream_t stream) {
    if (g_grid == 0) {
        int dev = 0, cus = 0;
        if (hipGetDevice(&dev) != hipSuccess || hipDeviceGetAttribute(&cus, hipDeviceAttributeMultiprocessorCount, dev) != hipSuccess) { fprintf(stderr, "kernel_launch: device query failed\n"); g_grid = -1; return; }
        if (hipFuncSetAttribute((const void*)mk_fwd, hipFuncAttributeMaxDynamicSharedMemorySize, LDS_BYTES) != hipSuccess) { fprintf(stderr, "kernel_launch: hipFuncSetAttribute failed\n"); g_grid = -1; return; }
        int per_cu = 0;
        if (hipOccupancyMaxActiveBlocksPerMultiprocessor(&per_cu, (const void*)mk_fwd, NWAVES * 64, LDS_BYTES) != hipSuccess || per_cu < 1) fprintf(stderr, "kernel_launch: occupancy query says %d per CU\n", per_cu);
        (void)hipGetLastError();
        g_grid = cus;
    }
    if (g_grid < 0) return;
    if (WS_END > ws_size) { fprintf(stderr, "kernel_launch: workspace too small (%zu)\n", ws_size); return; }
    char* ws = (char*)d_ws; float* out = (float*)d_out;
    Args a{};
    for (int i = 0; i < 22; ++i) a.in[i] = (const float*)d_in[i];
    a.out = out; a.ws = (unsigned char*)d_ws;
    (void)hipMemsetAsync(ws + WS_CTL, 0, CTL_ZERO_BYTES, stream);
    mk(stream, a, 0, 12);
}
```

```cpp
#include <hip/hip_runtime.h>
#include <cstdio>
#include <cstdint>

constexpr int BATCH = 4, SEQ = 4096, T = BATCH * SEQ, D = 2048;
constexpr int HG_H = 8, HG_DK = 128, HG_DV = 128, HG_K = 1024, HG_V = 1024;
constexpr int GM_G = 8, GM_CH = 128, GM_W = 1024, GM_CHUNK = 128;
constexpr int IN_W = 6144;
constexpr int ZQ = 0, ZF = 1024, ZI = 2048, ZG = 3072, ZU = 4096, ZV = 5120;
constexpr int NE = 32, TOPK = 4, DFF = 2048;
constexpr int PLE = 256;
constexpr float RMS_EPS = 1e-6f, LN_EPS = 1e-5f;
constexpr int MT = 128;
constexpr int MAXTILES = 576, RMAX = MAXTILES * MT;

__device__ __forceinline__ float gelu_erf(float x) { return 0.5f * x * (1.f + erff(x * 0.70710678118f)); }
__device__ __forceinline__ float sigmoidf(float x) { return 1.f / (1.f + expf(-x)); }
__device__ __forceinline__ float wave_sum(float v) {
#pragma unroll
    for (int o = 32; o >= 1; o >>= 1) v += __shfl_xor(v, o);
    return v;
}

#define LAS __attribute__((address_space(3)))
#define GAS __attribute__((address_space(1)))
typedef unsigned short bf16_t;
typedef short bf16x8 __attribute__((ext_vector_type(8)));
typedef float f32x4 __attribute__((ext_vector_type(4)));
typedef float f32x2 __attribute__((ext_vector_type(2)));
typedef unsigned u32x4 __attribute__((ext_vector_type(4)));
typedef unsigned u32x2 __attribute__((ext_vector_type(2)));
typedef GAS unsigned gu32;
#define RLX_AGENT __ATOMIC_RELAXED, __HIP_MEMORY_SCOPE_AGENT
#define LDS_WAIT() asm volatile("s_waitcnt lgkmcnt(0)" ::: "memory")
#define VM_WAIT() asm volatile("s_waitcnt vmcnt(0)" ::: "memory")

typedef __bf16 bf16x2_t __attribute__((ext_vector_type(2)));
__device__ __forceinline__ unsigned cvt_pk_bf16(float lo, float hi) { f32x2 v = {lo, hi}; bf16x2_t b = __builtin_convertvector(v, bf16x2_t); return __builtin_bit_cast(unsigned, b); }
__device__ __forceinline__ float bf2f(unsigned short b) { return __uint_as_float(((unsigned)b) << 16); }
__device__ __forceinline__ float bflo(unsigned w) { return __uint_as_float(w << 16); }
__device__ __forceinline__ float bfhi(unsigned w) { return __uint_as_float(w & 0xffff0000u); }
__device__ __forceinline__ unsigned short f2bf(float f) { return (unsigned short)__builtin_bit_cast(unsigned short, (__bf16)f); }
__device__ __forceinline__ float fast_sigmoid(float x) { return __builtin_amdgcn_rcpf(1.f + __builtin_amdgcn_exp2f(-1.44269504f * x)); }

__device__ __forceinline__ float fast_exp(float x) { return __builtin_amdgcn_exp2f(1.44269504f * x); }
__device__ __forceinline__ float fast_log(float x) { return 0.69314718f * __builtin_amdgcn_logf(x); }
__device__ __forceinline__ float gelu_fast(float v) {
    const float av = fabsf(v), t = __builtin_amdgcn_rcpf(1.0f + 0.2316418882f * av);
    float q = t * 0.5307027145f + (-0.7265760135f); q = q * t + 0.7107068705f; q = q * t + (-0.142248368f); q = q * t + 0.127414796f; q = q * t;
    const float e = __builtin_amdgcn_exp2f((v * v) * (-0.72134752044f)), m = v * (q * e);
    return v < 0.f ? m : v - m;
}
__device__ __forceinline__ float ld_agent_f(const float* p) { return __uint_as_float(__hip_atomic_load((const unsigned*)p, __ATOMIC_RELAXED, __HIP_MEMORY_SCOPE_AGENT)); }
__device__ __forceinline__ int ld_agent_i(const int* p) { return (int)__hip_atomic_load((const unsigned*)p, __ATOMIC_RELAXED, __HIP_MEMORY_SCOPE_AGENT); }
__device__ __forceinline__ unsigned pack4_fp8(float a, float b, float c, float d) { int r = __builtin_amdgcn_cvt_pk_fp8_f32(a, b, 0, false); r = __builtin_amdgcn_cvt_pk_fp8_f32(c, d, r, true); return (unsigned)r; }
__device__ __forceinline__ float clamp_f8(float v) { return __builtin_amdgcn_fmed3f(v, -440.f, 440.f); }
__device__ __forceinline__ unsigned pack4_fp8c(float a, float b, float c, float d) { return pack4_fp8(clamp_f8(a), clamp_f8(b), clamp_f8(c), clamp_f8(d)); }
typedef float f32x2u __attribute__((ext_vector_type(2)));
__device__ __forceinline__ void unpack4_fp8(unsigned w, float (&o)[4]) { const f32x2u lo = __builtin_amdgcn_cvt_pk_f32_fp8((int)w, false), hi = __builtin_amdgcn_cvt_pk_f32_fp8((int)w, true); o[0] = lo[0]; o[1] = lo[1]; o[2] = hi[0]; o[3] = hi[1]; }
#ifndef MOE_FP8
#define MOE_FP8 1
#endif
constexpr float F8_WSCALE = 256.f, F8_XSCALE = 16.f, F8_ASCALE = 4.f, F8_YSCALE = 64.f, F8_MSCALE = 8.f;
#ifndef OUT_FP8
#define OUT_FP8 0
#endif
#ifndef F8_MFMA_SCALE
#define F8_MFMA_SCALE 0
#endif
typedef int i32x8 __attribute__((ext_vector_type(8)));
typedef int i32x4 __attribute__((ext_vector_type(4)));
#ifndef X1_LO
#define X1_LO 0
#endif
#ifndef NT_MASK
#define NT_MASK 26
#endif
#define NTLD(g, p) (((NT_MASK >> (g)) & 1) ? __builtin_nontemporal_load(p) : *(p))
#ifndef MOE_WGM
#define MOE_WGM 4
#endif
constexpr int LISTCAP = T;
constexpr int MOE_MAXTILES = 288;
constexpr int MOE_RMAX = MOE_MAXTILES * 256;

namespace pg8 {
constexpr int BM = 256, BK = 64, HALF = 128, HTB = HALF * BK * 2  , STAGE_BYTES = 8 * HTB, NXCD = 8, WGM = 8;
__host__ __device__ __forceinline__ int lds_byte(int r, int c) { const int st = (r >> 4) * 2 + (c >> 5), rr = r & 15, cc = c & 31, ob = rr * 64 + cc * 2; return st * 1024 + (ob ^ (((ob >> 9) & 1) << 5)); }
__host__ __device__ __forceinline__ void stage_rc(int b, int& R, int& C) { const int st = b / 1024, sb = b % 1024, swz = sb ^ (((sb >> 9) & 1) << 5); R = (st >> 1) * 16 + swz / 64; C = (st & 1) * 32 + (swz % 64) / 2; }
__host__ __device__ __forceinline__ int perm32(int rho) { const int n = rho >> 4, i = rho & 15; return 8 * (i >> 2) + 4 * n + (i & 3); }

struct Unit { int pm, pn, e, gbase; };
struct Gemm { const bf16_t* A; const bf16_t* Bt; const int* rowidx; long long strideE; int K; int maxrow; };

__device__ __forceinline__ bool tile_order(int i, int G, int c, int nM, int nN, int& pm, int& pn, int wgm = WGM) {
    const int nwg = nM * nN; const long L = (long)i * G + c; if (L >= nwg) return false;
    int wgid = (int)L; { const int q = nwg / NXCD, r = nwg % NXCD, xcd = wgid % NXCD, off = wgid / NXCD; wgid = (xcd < r ? xcd * (q + 1) : r * (q + 1) + (xcd - r) * q) + off; }
    const int nig = wgm * nN, gid = wgid / nig, fm = gid * wgm, gsz = (nM - fm) < wgm ? (nM - fm) : wgm;
    pm = fm + ((wgid % nig) % gsz); pn = (wgid % nig) / gsz; return true;
}
struct StaticOrder {
    int nM, nN, G, c, i0, nr, wgm;
    __device__ void init(int M, int N, int G_, int c_, int i0_ = 0, int nr_ = 1 << 30, int wgm_ = WGM) { nM = M / BM; nN = N / BM; G = G_; c = c_; i0 = i0_; nr = nr_; wgm = wgm_; }
    __device__ __forceinline__ bool next(int i, Unit& u) const { u.e = 0; u.gbase = 0; if (i >= nr) return false; return tile_order(i + i0, G, c, nM, nN, u.pm, u.pn, wgm); }
};
struct MoeOrder {
    int nM, nN, G, c; const LAS int* tile_e; const LAS int* tstart;
    __device__ __forceinline__ bool next(int i, Unit& u) const {
        if (!tile_order(i, G, c, nM, nN, u.pm, u.pn, MOE_WGM)) return false;
        const int e = __builtin_amdgcn_readfirstlane(tile_e[u.pm]); u.e = e;
        u.gbase = e * LISTCAP + (u.pm - __builtin_amdgcn_readfirstlane(tstart[e])) * BM; return true;
    }
};

struct EpiBf16 {
    static constexpr bool ACC_INIT = false;
    bf16_t* O; int ldc;
    __device__ __forceinline__ void operator()(const f32x4 (&acc)[2][2][4][2], const Unit& u, int wr, int wc, int fr, int fq) const {
        bf16_t* base = O + (size_t)(u.pm * BM + wr * 64 + fr) * ldc + u.pn * BM + wc * 32 + 8 * fq;
#pragma unroll
        for (int ai = 0; ai < 2; ++ai)
#pragma unroll
            for (int m = 0; m < 4; ++m) { bf16_t* rowp = base + (size_t)(ai * HALF + m * 16) * ldc;
#pragma unroll
                for (int bj = 0; bj < 2; ++bj) { const f32x4 v0 = acc[ai][bj][m][0], v1 = acc[ai][bj][m][1];
                    u32x4 w; w.x = cvt_pk_bf16(v0[0], v0[1]); w.y = cvt_pk_bf16(v0[2], v0[3]); w.z = cvt_pk_bf16(v1[0], v1[1]); w.w = cvt_pk_bf16(v1[2], v1[3]);
                    *(u32x4*)(rowp + bj * HALF) = w; } }
    }
};
struct EpiResF32Bf16 {
    static constexpr bool ACC_INIT = true;
    const float* res; bf16_t* XH; bf16_t* XL; bf16_t* XB;
    __device__ __forceinline__ void init(f32x4 (&acc)[2][2][4][2], const Unit& u, int wr, int wc, int fr, int fq) const {
        const size_t o0 = (size_t)(u.pm * BM + wr * 64 + fr) * D + u.pn * BM + wc * 32 + 8 * fq;
#pragma unroll
        for (int ai = 0; ai < 2; ++ai)
#pragma unroll
            for (int m = 0; m < 4; ++m)
#pragma unroll
                for (int bj = 0; bj < 2; ++bj) { const size_t o = o0 + (size_t)(ai * HALF + m * 16) * D + bj * HALF; acc[ai][bj][m][0] = NTLD(1, (const f32x4*)(res + o)); acc[ai][bj][m][1] = NTLD(1, (const f32x4*)(res + o + 4)); }
    }
    __device__ __forceinline__ void operator()(const f32x4 (&acc)[2][2][4][2], const Unit& u, int wr, int wc, int fr, int fq) const {
        const size_t o0 = (size_t)(u.pm * BM + wr * 64 + fr) * D + u.pn * BM + wc * 32 + 8 * fq;
#pragma unroll
        for (int ai = 0; ai < 2; ++ai)
#pragma unroll
            for (int m = 0; m < 4; ++m) { const size_t o = o0 + (size_t)(ai * HALF + m * 16) * D;
#pragma unroll
                for (int bj = 0; bj < 2; ++bj) {
                    const f32x4 v0 = acc[ai][bj][m][0], v1 = acc[ai][bj][m][1];
                    u32x4 wh; wh.x = cvt_pk_bf16(v0[0], v0[1]); wh.y = cvt_pk_bf16(v0[2], v0[3]); wh.z = cvt_pk_bf16(v1[0], v1[1]); wh.w = cvt_pk_bf16(v1[2], v1[3]);
                    u32x4 wl; wl.x = cvt_pk_bf16(v0[0] - bflo(wh.x), v0[1] - bfhi(wh.x)); wl.y = cvt_pk_bf16(v0[2] - bflo(wh.y), v0[3] - bfhi(wh.y)); wl.z = cvt_pk_bf16(v1[0] - bflo(wh.z), v1[1] - bfhi(wh.z)); wl.w = cvt_pk_bf16(v1[2] - bflo(wh.w), v1[3] - bfhi(wh.w));
                    *(u32x4*)(XH + o + bj * HALF) = wh; if (X1_LO) *(u32x4*)(XL + o + bj * HALF) = wl;
#if MOE_FP8
                    u32x2 w; w.x = pack4_fp8c(v0[0] * F8_XSCALE, v0[1] * F8_XSCALE, v0[2] * F8_XSCALE, v0[3] * F8_XSCALE); w.y = pack4_fp8c(v1[0] * F8_XSCALE, v1[1] * F8_XSCALE, v1[2] * F8_XSCALE, v1[3] * F8_XSCALE);
                    *(u32x2*)((unsigned char*)XB + o + bj * HALF) = w; }
#endif
            }
    }
};
struct EpiSwiglu {
    static constexpr bool ACC_INIT = false;
    bf16_t* ACT; const float* rs; const float* bgu;
    __device__ __forceinline__ void operator()(const f32x4 (&acc)[2][2][4][2], const Unit& u, int wr, int wc, int fr, int fq) const {
        const int a0 = u.pn * HALF + wc * 32 + 8 * fq;
        const float* bp = bgu + (size_t)u.e * (2 * DFF) + 2 * a0;
        const f32x4 b0 = *(const f32x4*)bp, b1 = *(const f32x4*)(bp + 4), b2 = *(const f32x4*)(bp + 8), b3 = *(const f32x4*)(bp + 12);
        const float bg[8] = {b0[0], b0[2], b1[0], b1[2], b2[0], b2[2], b3[0], b3[2]}, bu[8] = {b0[1], b0[3], b1[1], b1[3], b2[1], b2[3], b3[1], b3[3]};
        const float* rsp = rs + u.gbase + wr * 64 + fr;
        bf16_t* base = ACT + (size_t)(u.pm * BM + wr * 64 + fr) * DFF + a0;
        float scv[2][4];
#pragma unroll
        for (int ai = 0; ai < 2; ++ai)
#pragma unroll
            for (int m = 0; m < 4; ++m) scv[ai][m] = rsp[ai * HALF + m * 16];
#pragma unroll
        for (int ai = 0; ai < 2; ++ai)
#pragma unroll
            for (int m = 0; m < 4; ++m) { const float sc = scv[ai][m] * (MOE_FP8 ? 1.f / (F8_WSCALE * F8_XSCALE) : 1.f); float a[8];
                const f32x2 sc2 = (f32x2){sc, sc}, k2 = (f32x2){-1.702f * 1.44269504f, -1.702f * 1.44269504f}, one2 = (f32x2){1.f, 1.f}, as2 = MOE_FP8 ? (f32x2){F8_ASCALE, F8_ASCALE} : one2;
#pragma unroll
                for (int n = 0; n < 2; ++n)
#pragma unroll
                    for (int jp = 0; jp < 2; ++jp) {
                        f32x2 g = (f32x2){acc[ai][0][m][n][2 * jp], acc[ai][0][m][n][2 * jp + 1]} * sc2 + (f32x2){bg[4 * n + 2 * jp], bg[4 * n + 2 * jp + 1]};
                        f32x2 up = (f32x2){acc[ai][1][m][n][2 * jp], acc[ai][1][m][n][2 * jp + 1]} * sc2 + (f32x2){bu[4 * n + 2 * jp], bu[4 * n + 2 * jp + 1]};
                        g.x = fminf(g.x, 7.f); g.y = fminf(g.y, 7.f); up.x = __builtin_amdgcn_fmed3f(up.x, -7.f, 7.f); up.y = __builtin_amdgcn_fmed3f(up.y, -7.f, 7.f);
                        const f32x2 up1 = up * as2 + as2;
                        const f32x2 tt = g * k2; f32x2 dd = (f32x2){__builtin_amdgcn_exp2f(tt.x), __builtin_amdgcn_exp2f(tt.y)}; dd = dd + one2;
                        const f32x2 rr2 = (f32x2){__builtin_amdgcn_rcpf(dd.x), __builtin_amdgcn_rcpf(dd.y)};
                        const f32x2 a2 = up1 * g * rr2; a[4 * n + 2 * jp] = a2.x; a[4 * n + 2 * jp + 1] = a2.y; }
#if MOE_FP8
                u32x2 w; w.x = pack4_fp8(a[0], a[1], a[2], a[3]); w.y = pack4_fp8(a[4], a[5], a[6], a[7]);
                *(u32x2*)((unsigned char*)ACT + (size_t)(u.pm * BM + wr * 64 + fr + ai * HALF + m * 16) * DFF + a0) = w; }
#else
                u32x4 w; w.x = cvt_pk_bf16(a[0], a[1]); w.y = cvt_pk_bf16(a[2], a[3]); w.z = cvt_pk_bf16(a[4], a[5]); w.w = cvt_pk_bf16(a[6], a[7]);
                *(u32x4*)(base + (size_t)(ai * HALF + m * 16) * DFF) = w; }
#endif
    }
};
struct EpiDown {
    static constexpr bool ACC_INIT = false;
    bf16_t* Y; const float* gt; const float* bdn;
    __device__ __forceinline__ void operator()(const f32x4 (&acc)[2][2][4][2], const Unit& u, int wr, int wc, int fr, int fq) const {
        const int c0 = u.pn * BM + wc * 32 + 8 * fq;
        const float* bp = bdn + (size_t)u.e * D + c0;
        f32x4 bv[2][2];
#pragma unroll
        for (int bj = 0; bj < 2; ++bj) { bv[bj][0] = *(const f32x4*)(bp + bj * HALF); bv[bj][1] = *(const f32x4*)(bp + bj * HALF + 4); }
        const float* gp = gt + u.gbase + wr * 64 + fr;
        bf16_t* base = Y + (size_t)(u.pm * BM + wr * 64 + fr) * D + c0;
        float ggv[2][4];
#pragma unroll
        for (int ai = 0; ai < 2; ++ai)
#pragma unroll
            for (int m = 0; m < 4; ++m) ggv[ai][m] = gp[ai * HALF + m * 16];
#pragma unroll
        for (int ai = 0; ai < 2; ++ai)
#pragma unroll
            for (int m = 0; m < 4; ++m) { const float gg = ggv[ai][m]; bf16_t* rowp = base + (size_t)(ai * HALF + m * 16) * D;
#pragma unroll
                for (int bj = 0; bj < 2; ++bj) {
#if MOE_FP8
                    const float gy = gg * F8_YSCALE, sa = gy * (1.f / (F8_WSCALE * F8_ASCALE));
                    const f32x4 v0 = acc[ai][bj][m][0] * sa + bv[bj][0] * gy, v1 = acc[ai][bj][m][1] * sa + bv[bj][1] * gy;
                    u32x2 w; w.x = pack4_fp8c(v0[0], v0[1], v0[2], v0[3]); w.y = pack4_fp8c(v1[0], v1[1], v1[2], v1[3]);
                    *(u32x2*)((unsigned char*)Y + (size_t)(u.pm * BM + wr * 64 + fr + ai * HALF + m * 16) * D + c0 + bj * HALF) = w; } }
#else
                    const f32x4 v0 = (acc[ai][bj][m][0] + bv[bj][0]) * gg, v1 = (acc[ai][bj][m][1] + bv[bj][1]) * gg;
                    u32x4 w; w.x = cvt_pk_bf16(v0[0], v0[1]); w.y = cvt_pk_bf16(v0[2], v0[3]); w.z = cvt_pk_bf16(v1[0], v1[1]); w.w = cvt_pk_bf16(v1[2], v1[3]);
                    *(u32x4*)(rowp + bj * HALF) = w; } }
#endif
    }
};
struct EpiPleGate {
    static constexpr bool ACC_INIT = false;
    const bf16_t* X2B; const float* rstd2; const bf16_t* PLEB; bf16_t* X3B; float* ssq;
    __device__ __forceinline__ void operator()(const f32x4 (&acc)[2][2][4][2], const Unit& u, int wr, int wc, int fr, int fq) const {
        const int row0 = u.pm * BM + wr * 64 + fr;
        const size_t o0 = (size_t)row0 * D + u.pn * BM + wc * 32 + 8 * fq;
#pragma unroll
        for (int ai = 0; ai < 2; ++ai) {
            u32x4 xw[4][2], pw[4][2]; float rsv[4];
#pragma unroll
            for (int m = 0; m < 4; ++m) { rsv[m] = rstd2[row0 + ai * HALF + m * 16];
#pragma unroll
                for (int bj = 0; bj < 2; ++bj) { const size_t o = o0 + (size_t)(ai * HALF + m * 16) * D + bj * HALF; xw[m][bj] = *(const u32x4*)(X2B + o); pw[m][bj] = *(const u32x4*)(PLEB + o); } }
#pragma unroll
            for (int m = 0; m < 4; ++m) { const size_t o = o0 + (size_t)(ai * HALF + m * 16) * D; const float rs = rsv[m] * (MOE_FP8 ? 1.f / (F8_WSCALE * F8_XSCALE) : 1.f); float s = 0.f;
#pragma unroll
                for (int bj = 0; bj < 2; ++bj) { const u32x4 xq = xw[m][bj], pq = pw[m][bj];
                    const float xv[8] = {bflo(xq.x), bfhi(xq.x), bflo(xq.y), bfhi(xq.y), bflo(xq.z), bfhi(xq.z), bflo(xq.w), bfhi(xq.w)};
                    const float pl[8] = {bflo(pq.x), bfhi(pq.x), bflo(pq.y), bfhi(pq.y), bflo(pq.z), bfhi(pq.z), bflo(pq.w), bfhi(pq.w)};
                    float v[8];
#pragma unroll
                    for (int j = 0; j < 4; ++j) { v[j] = xv[j] + fast_sigmoid(acc[ai][bj][m][0][j] * rs) * pl[j]; v[4 + j] = xv[4 + j] + fast_sigmoid(acc[ai][bj][m][1][j] * rs) * pl[4 + j]; s += v[j] * v[j] + v[4 + j] * v[4 + j]; }
                    u32x4 w; w.x = cvt_pk_bf16(v[0], v[1]); w.y = cvt_pk_bf16(v[2], v[3]); w.z = cvt_pk_bf16(v[4], v[5]); w.w = cvt_pk_bf16(v[6], v[7]);
                    *(u32x4*)(X3B + o + bj * HALF) = w; }
                s += __shfl_xor(s, 16); s += __shfl_xor(s, 32);
                if (fq == 0) atomicAdd(ssq + row0 + ai * HALF + m * 16, s); }
            asm volatile("" ::: "memory"); }
    }
};

struct EpiPleGateNorm {
    static constexpr bool ACC_INIT = false;
    const bf16_t* X2B; const float* rstd2; const bf16_t* PLEB; float* out; float* ssq; unsigned* pcnt; const float* gfin;
    __device__ __forceinline__ void operator()(f32x4 (&acc)[2][2][4][2], const Unit& u, int wr, int wc, int fr, int fq) const {
        const int row0 = u.pm * BM + wr * 64 + fr;
        const size_t o0 = (size_t)row0 * D + u.pn * BM + wc * 32 + 8 * fq;
#pragma unroll
        for (int ai = 0; ai < 2; ++ai) {
            u32x4 xw[4][2], pw[4][2]; float rsv[4];
#pragma unroll
            for (int m = 0; m < 4; ++m) { rsv[m] = rstd2[row0 + ai * HALF + m * 16];
#pragma unroll
                for (int bj = 0; bj < 2; ++bj) { const size_t o = o0 + (size_t)(ai * HALF + m * 16) * D + bj * HALF; xw[m][bj] = NTLD(0, (const u32x4*)(X2B + o)); pw[m][bj] = NTLD(0, (const u32x4*)(PLEB + o)); } }
#pragma unroll
            for (int m = 0; m < 4; ++m) { const float rs = rsv[m] * (MOE_FP8 ? 1.f / (F8_WSCALE * F8_XSCALE) : 1.f); float s = 0.f;
#pragma unroll
                for (int bj = 0; bj < 2; ++bj) { const u32x4 xq = xw[m][bj], pq = pw[m][bj];
                    const float xv[8] = {bflo(xq.x), bfhi(xq.x), bflo(xq.y), bfhi(xq.y), bflo(xq.z), bfhi(xq.z), bflo(xq.w), bfhi(xq.w)};
                    const float pl[8] = {bflo(pq.x), bfhi(pq.x), bflo(pq.y), bfhi(pq.y), bflo(pq.z), bfhi(pq.z), bflo(pq.w), bfhi(pq.w)};
#pragma unroll
                    for (int j = 0; j < 4; ++j) { const float v0 = xv[j] + fast_sigmoid(acc[ai][bj][m][0][j] * rs) * pl[j], v1 = xv[4 + j] + fast_sigmoid(acc[ai][bj][m][1][j] * rs) * pl[4 + j];
                        acc[ai][bj][m][0][j] = v0; acc[ai][bj][m][1][j] = v1; s += v0 * v0 + v1 * v1; } }
                s += __shfl_xor(s, 16); s += __shfl_xor(s, 32);
                if (fq == 0) atomicAdd(ssq + row0 + ai * HALF + m * 16, s); }
            asm volatile("" ::: "memory"); }
        asm volatile("s_waitcnt vmcnt(0)" ::: "memory");
        __builtin_amdgcn_s_barrier();
        if (threadIdx.x == 0) {
            unsigned* pc = pcnt + 64 * u.pm;
            (void)__hip_atomic_fetch_add(pc, 1u, __ATOMIC_RELAXED, __HIP_MEMORY_SCOPE_AGENT);
            for (unsigned sp = 0; __hip_atomic_load(pc, __ATOMIC_RELAXED, __HIP_MEMORY_SCOPE_AGENT) < (unsigned)(D / BM) && sp < (1u << 20); ++sp) __builtin_amdgcn_s_sleep(1);
        }
        asm volatile("" ::: "memory"); __builtin_amdgcn_s_barrier(); asm volatile("" ::: "memory");
        const int c0 = u.pn * BM + wc * 32 + 8 * fq;
        f32x4 gv[2][2];
#pragma unroll
        for (int bj = 0; bj < 2; ++bj) { gv[bj][0] = *(const f32x4*)(gfin + c0 + bj * HALF); gv[bj][1] = *(const f32x4*)(gfin + c0 + bj * HALF + 4); }
        float rr[2][4];
#pragma unroll
        for (int ai = 0; ai < 2; ++ai)
#pragma unroll
            for (int m = 0; m < 4; ++m) rr[ai][m] = rsqrtf(ld_agent_f(ssq + row0 + ai * HALF + m * 16) * (1.f / D) + RMS_EPS);
#pragma unroll
        for (int ai = 0; ai < 2; ++ai)
#pragma unroll
            for (int m = 0; m < 4; ++m) { const size_t o = o0 + (size_t)(ai * HALF + m * 16) * D;
#pragma unroll
                for (int bj = 0; bj < 2; ++bj) { const f32x4 w0 = acc[ai][bj][m][0] * rr[ai][m] * gv[bj][0], w1 = acc[ai][bj][m][1] * rr[ai][m] * gv[bj][1]; if ((NT_MASK >> 5) & 1) { __builtin_nontemporal_store(w0, (f32x4*)(out + o + bj * HALF)); __builtin_nontemporal_store(w1, (f32x4*)(out + o + bj * HALF + 4)); } else { *(f32x4*)(out + o + bj * HALF) = w0; *(f32x4*)(out + o + bj * HALF + 4) = w1; } } }
    }
};

struct NoPre { __device__ __forceinline__ void operator()() const {} };
template <class Epi, class Sched, bool GATHER, bool FP8 = false, class Pre = NoPre>
__device__ __forceinline__ void gemm_phase(LAS unsigned char* lds, const Gemm g, const Sched& S, const Epi& E, const Pre& pre = Pre()) {
    const int tid = threadIdx.x, wid = __builtin_amdgcn_readfirstlane(tid >> 6), lane = tid & 63, wr = wid >> 2, wc = wid & 3, fr = lane & 15, fq = lane >> 4;
    const int K = g.K, nt = K / BK;
    unsigned voffB[2];
#pragma unroll
    for (int i = 0; i < 2; ++i) { int R, C; stage_rc(tid * 16 + i * 8192, R, C); const int Rb = (R & ~31) + perm32(R & 31); voffB[i] = (unsigned)(Rb * K + C) * 2u; }
    const size_t kstep = (size_t)(BK * 2);
    const size_t hstep = (size_t)HALF * K * 2;
    const size_t tstep = 2 * hstep;
    const unsigned ldsw = (unsigned)wid * 1024u;
    const int aoff = lds_byte(wr * 64 + fr, fq * 8), boff = lds_byte(wc * 32 + fr, fq * 8);
    const char* Ab = (const char*)g.A;
#define PG8_SA(b, h) (((b) * 2 + (h)) * HTB)
#define PG8_SB(b, h) ((4 + (b) * 2 + (h)) * HTB)
#define PG8_STAGE(bufoff, gbase, voff) do { _Pragma("unroll") for (int _i = 0; _i < 2; ++_i) \
        __builtin_amdgcn_global_load_lds((const unsigned*)((const char*)(gbase) + (voff)[_i]), (LAS unsigned*)(lds + (bufoff) + ldsw + _i * 8192), 16, 0, 0); } while (0)
#define PG8_STAGE_A(bufoff, VO, h, koff) do { const char* _ab = Ab + (size_t)(koff); asm volatile("" : "+s"(_ab)); _Pragma("unroll") for (int _i = 0; _i < 2; ++_i) \
        __builtin_amdgcn_global_load_lds((const unsigned*)(_ab + (VO)[h][_i]), (LAS unsigned*)(lds + (bufoff) + ldsw + _i * 8192), 16, 0, 0); } while (0)
#define PG8_LOAD_VO(VO, U) do { int _t = tid; asm volatile("" : "+v"(_t)); _Pragma("unroll") for (int _i = 0; _i < 2; ++_i) { int _R, _C; stage_rc(_t * 16 + _i * 8192, _R, _C); _Pragma("unroll") for (int _h = 0; _h < 2; ++_h) { \
        unsigned _row; if (GATHER) { _row = (unsigned)g.rowidx[(U).gbase + _h * HALF + _R]; _row = _row < (unsigned)g.maxrow ? _row : (unsigned)g.maxrow; } else _row = (unsigned)((U).pm * BM + _h * HALF + _R); \
        (VO)[_h][_i] = (_row * (unsigned)K + (unsigned)_C) * 2u; } } } while (0)
#define PG8_LDA(dst, b, h) do { _Pragma("unroll") for (int m = 0; m < 4; ++m) { if constexpr (FP8) { const i32x4 _l = *(const LAS i32x4*)(lds + PG8_SA(b, h) + aoff + m * 2048), _h = *(const LAS i32x4*)(lds + PG8_SA(b, h) + aoff + m * 2048 + 1024); \
            dst##8[m] = __builtin_shufflevector(_l, _h, 0, 1, 2, 3, 4, 5, 6, 7); } else { _Pragma("unroll") for (int k = 0; k < 2; ++k) dst[m][k] = *(const LAS bf16x8*)(lds + PG8_SA(b, h) + aoff + m * 2048 + k * 1024); } } } while (0)
#define PG8_LDB(dst, b, h) do { _Pragma("unroll") for (int n = 0; n < 2; ++n) { if constexpr (FP8) { const i32x4 _l = *(const LAS i32x4*)(lds + PG8_SB(b, h) + boff + n * 2048), _h = *(const LAS i32x4*)(lds + PG8_SB(b, h) + boff + n * 2048 + 1024); \
            dst##8[n] = __builtin_shufflevector(_l, _h, 0, 1, 2, 3, 4, 5, 6, 7); } else { _Pragma("unroll") for (int k = 0; k < 2; ++k) dst[n][k] = *(const LAS bf16x8*)(lds + PG8_SB(b, h) + boff + n * 2048 + k * 1024); } } } while (0)
#define PG8_MMA(ai, bj, At, Bt) do { __builtin_amdgcn_s_setprio(1); _Pragma("unroll") for (int m = 0; m < 4; ++m) _Pragma("unroll") for (int n = 0; n < 2; ++n) { \
        if constexpr (FP8) acc[ai][bj][m][n] = __builtin_amdgcn_mfma_scale_f32_16x16x128_f8f6f4(Bt##8[n], At##8[m], acc[ai][bj][m][n], 0, 0, 0, F8_MFMA_SCALE, 0, F8_MFMA_SCALE); \
        else { _Pragma("unroll") for (int k = 0; k < 2; ++k) acc[ai][bj][m][n] = __builtin_amdgcn_mfma_f32_16x16x32_bf16(Bt[n][k], At[m][k], acc[ai][bj][m][n], 0, 0, 0); } } \
        __builtin_amdgcn_s_setprio(0); } while (0)
#define PG8_WAIT_V(n) asm volatile("s_waitcnt vmcnt(" #n ")" ::: "memory")
#define PG8_WAIT_L(n) asm volatile("s_waitcnt lgkmcnt(" #n ")" ::: "memory")
#define PG8_BAR __builtin_amdgcn_s_barrier()
#define PG8_SCHED __builtin_amdgcn_sched_barrier(0)
    Unit cur, nxt; int ui = 0;
    if (!S.next(0, cur)) { pre(); return; }
    bool has_next = S.next(1, nxt);
    unsigned vo[2][2], nvo[2][2];
    PG8_LOAD_VO(vo, cur);
    if (has_next) PG8_LOAD_VO(nvo, nxt); else {
#pragma unroll
        for (int h = 0; h < 2; ++h) { nvo[h][0] = vo[h][0]; nvo[h][1] = vo[h][1]; } }
    f32x4 acc[2][2][4][2];
    if constexpr (Epi::ACC_INIT) E.init(acc, cur, wr, wc, fr, fq); else {
#pragma unroll
    for (int a = 0; a < 2; ++a)
#pragma unroll
        for (int b = 0; b < 2; ++b)
#pragma unroll
            for (int m = 0; m < 4; ++m)
#pragma unroll
                for (int n = 0; n < 2; ++n) acc[a][b][m][n] = (f32x4){0.f, 0.f, 0.f, 0.f}; }
    bf16x8 At[4][2], B0[2][2], B1[2][2]; i32x8 At8[4], B08[2], B18[2];
    const char* cB = (const char*)g.Bt + ((size_t)cur.e * (size_t)g.strideE) * 2 + (size_t)cur.pn * tstep;
    PG8_STAGE(PG8_SB(0, 0), cB, voffB); PG8_STAGE(PG8_SB(0, 1), cB + hstep, voffB);
    pre();
    PG8_STAGE_A(PG8_SA(0, 0), vo, 0, 0); PG8_STAGE_A(PG8_SA(0, 1), vo, 1, 0);
    if (wr == 1) PG8_BAR;
    PG8_WAIT_V(2); PG8_BAR;
    PG8_STAGE(PG8_SB(1, 0), cB + kstep, voffB); PG8_STAGE_A(PG8_SA(1, 0), vo, 0, kstep); PG8_STAGE(PG8_SB(1, 1), cB + hstep + kstep, voffB);
    PG8_WAIT_V(6); PG8_BAR;
    for (;;) {
        const char* nB = has_next ? (const char*)g.Bt + ((size_t)nxt.e * (size_t)g.strideE) * 2 + (size_t)nxt.pn * tstep : cB;
        for (int t = 0; t < nt; t += 2) {
            const bool last = (t == nt - 2);
            const size_t k1 = (size_t)(t + 1) * kstep, k2 = last ? 0 : (size_t)(t + 2) * kstep, k3 = k2 + kstep;
            const char* b2 = last ? nB : cB + (size_t)(t + 2) * kstep; const char* b3 = b2 + kstep;
            PG8_LDB(B0, 0, 0); PG8_LDB(B1, 0, 1); PG8_SCHED; PG8_LDA(At, 0, 0); PG8_STAGE_A(PG8_SA(1, 1), vo, 1, k1);
            if (last) {
#pragma unroll
                for (int h = 0; h < 2; ++h) { vo[h][0] = nvo[h][0]; vo[h][1] = nvo[h][1]; } }
            PG8_WAIT_V(8); PG8_WAIT_L(0); PG8_BAR; PG8_MMA(0, 0, At, B0); PG8_MMA(0, 1, At, B1); PG8_BAR; PG8_SCHED;
            PG8_LDA(At, 0, 1); PG8_STAGE(PG8_SB(0, 0), b2, voffB); PG8_STAGE(PG8_SB(0, 1), b2 + hstep, voffB); PG8_STAGE_A(PG8_SA(0, 0), vo, 0, k2);
            PG8_WAIT_V(8); PG8_WAIT_L(0); PG8_BAR; PG8_MMA(1, 0, At, B0); PG8_MMA(1, 1, At, B1); PG8_BAR; PG8_SCHED;
            PG8_LDB(B0, 1, 0); PG8_LDB(B1, 1, 1); PG8_SCHED; PG8_LDA(At, 1, 0); PG8_STAGE_A(PG8_SA(0, 1), vo, 1, k2);
            PG8_WAIT_V(8); PG8_WAIT_L(0); PG8_BAR; PG8_MMA(0, 0, At, B0); PG8_MMA(0, 1, At, B1); PG8_BAR; PG8_SCHED;
            PG8_LDA(At, 1, 1); PG8_STAGE(PG8_SB(1, 0), b3, voffB); PG8_STAGE(PG8_SB(1, 1), b3 + hstep, voffB); PG8_STAGE_A(PG8_SA(1, 0), vo, 0, k3);
            PG8_WAIT_V(8); PG8_WAIT_L(0); PG8_BAR; PG8_MMA(1, 0, At, B0); PG8_MMA(1, 1, At, B1); PG8_BAR; PG8_SCHED;
        }
        if (wr == 0) PG8_BAR;
        E(acc, cur, wr, wc, fr, fq);
        if (!has_next) break;
        if constexpr (Epi::ACC_INIT) E.init(acc, nxt, wr, wc, fr, fq); else {
#pragma unroll
        for (int a = 0; a < 2; ++a)
#pragma unroll
            for (int b = 0; b < 2; ++b)
#pragma unroll
                for (int m = 0; m < 4; ++m)
#pragma unroll
                    for (int n = 0; n < 2; ++n) acc[a][b][m][n] = (f32x4){0.f, 0.f, 0.f, 0.f}; }
        cur = nxt; cB = nB; ++ui;
        has_next = S.next(ui + 1, nxt);
        if (has_next) PG8_LOAD_VO(nvo, nxt);
        if (wr == 1) PG8_BAR;
    }
    PG8_WAIT_V(0);
    PG8_BAR;
#undef PG8_SA
#undef PG8_SB
#undef PG8_STAGE
#undef PG8_STAGE_A
#undef PG8_LOAD_VO
#undef PG8_LDA
#undef PG8_LDB
#undef PG8_MMA
#undef PG8_WAIT_V
#undef PG8_WAIT_L
#undef PG8_BAR
#undef PG8_SCHED
}
}

constexpr size_t MiB = 1u << 20;
constexpr size_t WS_CTL = 0, CTL_ZERO_BYTES = 160 * 1024;
constexpr size_t WS_WIN = 1 * MiB;
constexpr size_t WS_WOUT = 25 * MiB;
constexpr size_t WS_WPG = 33 * MiB;
constexpr size_t WS_WPP = 41 * MiB;
constexpr size_t WS_WR = 42 * MiB;
constexpr size_t WS_PB = 43 * MiB;
constexpr size_t WS_XN = 51 * MiB;
constexpr size_t WS_ZB = 115 * MiB;
constexpr size_t WS_MIXB = 307 * MiB;
constexpr size_t WS_X1 = 371 * MiB;
constexpr size_t WS_X1B = 499 * MiB;
constexpr size_t WS_X2 = 563 * MiB;
constexpr size_t WS_X2B = 691 * MiB;
constexpr size_t WS_PLEB = 755 * MiB;
constexpr size_t WS_RSTD = 819 * MiB;
constexpr size_t WS_TOK = 820 * MiB;
constexpr size_t WS_LIST = 821 * MiB;
constexpr size_t WS_HG = 827 * MiB;
constexpr size_t WS_ACT = 1024 * MiB;
constexpr size_t WS_Y = 1312 * MiB;
constexpr size_t WS_WGU = 1600 * MiB;
constexpr size_t WS_WDN = 2112 * MiB;
constexpr size_t WS_END = 2368 * MiB;
constexpr int CW_CNT = 32768, CNT_STRIDE = 64;
constexpr int CW_BAR = 1024;
constexpr int CW_SSQ = 16384;
constexpr int CW_PCNT = 36864;
static_assert(CW_SSQ + T <= CW_CNT && CW_CNT + NE * CNT_STRIDE <= CW_PCNT && (CW_PCNT + 64 * 64) * 4 <= (int)CTL_ZERO_BYTES, "CTL region");

constexpr int RING_OFF = 0, RING_BYTES = 131072;
constexpr int PH_BYTES = 147456;
constexpr int MISC_OFF = PH_BYTES;
constexpr int LDS_BYTES = 163840;
constexpr int MI_BAR = 0;
constexpr int MI_NT = 8;
constexpr int MI_TSTART = 64;
constexpr int MI_TILEE = 128;
constexpr int NWAVES = 8;

#define XB_TMO      128
#define XB_XCNT(j)  (256  + 64 * (j))
#define XB_XSUB(j)  (1280 + 64 * (j))
#define XB_XGEN(j)  (2304 + 64 * (j))
#define XB_TOP      3328
#define XB_TOPGEN   3392
#define XCD_BAR_WORDS 3456
#define XB_SPIN_CAP (1u << 18)
__device__ __forceinline__ unsigned xb_ld(unsigned* p)              { return __hip_atomic_load(p, __ATOMIC_RELAXED, __HIP_MEMORY_SCOPE_AGENT); }
__device__ __forceinline__ unsigned xb_add(unsigned* p, unsigned v) { return __hip_atomic_fetch_add(p, v, __ATOMIC_RELAXED, __HIP_MEMORY_SCOPE_AGENT); }
__device__ __forceinline__ unsigned xb_xcc_id() { return (unsigned)__builtin_amdgcn_s_getreg((3 << 11) | 20) & 0xFu; }
#define XB_SPIN(cond, bar) do { unsigned _sp = 0; while (cond) { __builtin_amdgcn_s_sleep(1); \
    if ((++_sp & 255u) == 0u) { if (xb_ld(&(bar)[XB_TMO])) break; if (_sp > XB_SPIN_CAP) { atomicAdd(&(bar)[XB_TMO], 1u); break; } } } } while (0)
struct XcdBarrier { unsigned* bar; unsigned x; volatile LAS unsigned* st; };
__device__ __forceinline__ XcdBarrier xcd_barrier_post(unsigned* bar, volatile LAS unsigned* st) {
    XcdBarrier b; b.bar = bar; b.x = xb_xcc_id(); b.st = st;
    if (threadIdx.x == 0) (void)xb_add(&bar[XB_XCNT(b.x)], 1u);
    return b;
}
__device__ __forceinline__ void xcd_barrier_complete(unsigned* bar, unsigned x, unsigned& nloc, unsigned& nx) {
    const unsigned G = gridDim.x * gridDim.y * gridDim.z;
    unsigned sum, cnt, mine, sp = 0u;
    for (;;) {
        sum = 0u; cnt = 0u; mine = 0u;
#pragma unroll
        for (unsigned j = 0; j < 16; ++j) { const unsigned c = xb_ld(&bar[XB_XCNT(j)]); sum += c; cnt += (c > 0u) ? 1u : 0u; mine = (j == x) ? c : mine; }
        if (sum == G) break;
        __builtin_amdgcn_s_sleep(1);
        if ((++sp & 255u) == 0u) { if (xb_ld(&bar[XB_TMO])) break; if (sp > XB_SPIN_CAP) { atomicAdd(&bar[XB_TMO], 1u); break; } }
    }
    nloc = mine > 0u ? mine : 1u; nx = cnt > 0u ? cnt : 1u;
}
__device__ __forceinline__ void xcd_barrier(const XcdBarrier& b) {
    asm volatile("s_waitcnt vmcnt(0)" ::: "memory");
    __syncthreads();
    if (threadIdx.x == 0) {
        unsigned* bar = b.bar;
        __builtin_amdgcn_s_waitcnt(0);
        unsigned nloc = b.st[0], nx = b.st[1];
        if (nloc == 0u) { xcd_barrier_complete(bar, b.x, nloc, nx); b.st[0] = nloc; b.st[1] = nx; }
        const unsigned old = xb_add(&bar[XB_XSUB(b.x)], 1u);
        const unsigned gen = old / nloc;
        if (old + 1u == (gen + 1u) * nloc) {
            __builtin_amdgcn_fence(__ATOMIC_RELEASE, "agent");
            asm volatile("s_waitcnt vmcnt(0)" ::: "memory");
            const unsigned og = xb_add(&bar[XB_TOP], 1u);
            const unsigned tg = og / nx;
            if (og + 1u == (tg + 1u) * nx) xb_add(&bar[XB_TOPGEN], 1u);
            else XB_SPIN(xb_ld(&bar[XB_TOPGEN]) == tg, bar);
            __builtin_amdgcn_fence(__ATOMIC_ACQUIRE, "agent");
            xb_add(&bar[XB_XGEN(b.x)], 1u);
            asm volatile("s_waitcnt vmcnt(0)" ::: "memory");
        } else {
            XB_SPIN(xb_ld(&bar[XB_XGEN(b.x)]) == gen, bar);
            __builtin_amdgcn_fence(__ATOMIC_ACQUIRE, "agent");
            asm volatile("s_waitcnt vmcnt(0)" ::: "memory");
        }
    }
    __syncthreads();
}

template <int MAP>
__device__ __forceinline__ void cvt_tile(const float* __restrict__ W, int N, int K, int k0, int n0, bf16_t* __restrict__ WT, const float* __restrict__ kscale, LAS unsigned* scr, int lane) {
    const int kp = lane >> 4, nq = lane & 15;
    f32x4 v[16];
#pragma unroll
    for (int i = 0; i < 8; ++i)
#pragma unroll
        for (int r = 0; r < 2; ++r) v[2 * i + r] = *(const f32x4*)(W + (size_t)(k0 + 8 * i + 2 * kp + r) * N + n0 + 4 * nq);
    if (kscale) {
#pragma unroll
        for (int i = 0; i < 8; ++i)
#pragma unroll
            for (int r = 0; r < 2; ++r) v[2 * i + r] = v[2 * i + r] * kscale[k0 + 8 * i + 2 * kp + r];
    }
#pragma unroll
    for (int i = 0; i < 8; ++i)
#pragma unroll
        for (int j = 0; j < 4; ++j) scr[(4 * nq + j) * 33 + 4 * i + kp] = cvt_pk_bf16(v[2 * i][j], v[2 * i + 1][j]);
    LDS_WAIT();
    const int c = lane & 7;
#pragma unroll
    for (int it = 0; it < 8; ++it) {
        const int nl = (lane >> 3) + 8 * it, n = n0 + nl;
        const LAS unsigned* s = scr + nl * 33 + 4 * c;
        u32x4 o; o.x = s[0]; o.y = s[1]; o.z = s[2]; o.w = s[3];
        int row; if (MAP == 0) row = n; else { const int j = n >> 1; row = 256 * (j >> 7) + 128 * (n & 1) + (j & 127); }
        *(u32x4*)(WT + (size_t)row * K + k0 + 8 * c) = o;
    }
    LDS_WAIT();
}

__device__ __forceinline__ void f8_tile_load(f32x4 (&v)[16], const float* __restrict__ W, int N, int k0, int n0, int lane) {
    const int kp = lane >> 4, nq = lane & 15;
#pragma unroll
    for (int i = 0; i < 4; ++i)
#pragma unroll
        for (int r = 0; r < 4; ++r) v[4 * i + r] = __builtin_nontemporal_load((const f32x4*)(W + (size_t)(k0 + 16 * i + 4 * kp + r) * N + n0 + 4 * nq));
}
template <int MAP>
__device__ __forceinline__ void f8_tile_finish(const f32x4 (&v)[16], const LAS float* ksl, float mul, int K, int k0, int n0, unsigned char* __restrict__ WT, LAS unsigned* scr, int lane) {
    const int kp = lane >> 4, nq = lane & 15;
    f32x4 ks[4];
#pragma unroll
    for (int i = 0; i < 4; ++i) { if (ksl) ks[i] = *(const LAS f32x4*)(ksl + k0 + 16 * i + 4 * kp); else ks[i] = (f32x4){mul, mul, mul, mul}; }
#pragma unroll
    for (int i = 0; i < 4; ++i)
#pragma unroll
        for (int j = 0; j < 4; ++j) scr[(4 * nq + j) * 17 + 4 * i + kp] = pack4_fp8(v[4 * i][j] * ks[i][0], v[4 * i + 1][j] * ks[i][1], v[4 * i + 2][j] * ks[i][2], v[4 * i + 3][j] * ks[i][3]);
    LDS_WAIT();
    const int c = lane & 3;
#pragma unroll
    for (int it = 0; it < 4; ++it) {
        const int nl = (lane >> 2) + 16 * it, n = n0 + nl;
        const LAS unsigned* sp = scr + nl * 17 + 4 * c;
        u32x4 o; o.x = sp[0]; o.y = sp[1]; o.z = sp[2]; o.w = sp[3];
        int row; if (MAP == 0) row = n; else { const int j = n >> 1; row = 256 * (j >> 7) + 128 * (n & 1) + (j & 127); }
        __builtin_nontemporal_store(o, (u32x4*)(WT + (size_t)row * K + k0 + 16 * c));
    }
    LDS_WAIT();
}
template <int MAP>
__device__ __forceinline__ void f8_convert_experts(const float* __restrict__ W, int ne, int K, int N, unsigned char* __restrict__ WT, const LAS float* ksl, float mul, int first, int stride, LAS unsigned* scr, int lane) {
    const int nb = N / 64, per_e = (K / 64) * nb, total = ne * per_e;
    f32x4 va[16], vb[16];
#define F8_LOAD(V, KS, IT) do { const int _e = (IT) / per_e, _q = (IT) % per_e; f8_tile_load(V, W + (size_t)_e * K * N, N, 64 * (_q / nb), 64 * (_q % nb), lane); } while (0)
#define F8_FINISH(V, KS, IT) do { const int _e = (IT) / per_e, _q = (IT) % per_e; f8_tile_finish<MAP>(V, ksl, mul, K, 64 * (_q / nb), 64 * (_q % nb), WT + (size_t)_e * K * N, scr, lane); } while (0)
    int it = first;
    if (it >= total) return;
    F8_LOAD(va, ka, it);
    for (;;) {
        const int itn = it + stride, ln = itn < total ? itn : it;
        F8_LOAD(vb, kb, ln);
        F8_FINISH(va, ka, it);
        if (itn >= total) break;
        const int itm = itn + stride, lm = itm < total ? itm : itn;
        F8_LOAD(va, ka, lm);
        F8_FINISH(vb, kb, itn);
        if (itm >= total) break;
        it = itm;
    }
#undef F8_LOAD
#undef F8_FINISH
}

struct Args { const float* in[22]; float* out; unsigned char* ws; int ph_lo, ph_hi, li, pad; };

__global__ void __launch_bounds__(NWAVES * 64, 2) mk_fwd(Args args) {
    extern __shared__ __attribute__((aligned(16))) unsigned char lds_raw[];
    LAS unsigned char* lds = (LAS unsigned char*)lds_raw;
    volatile LAS unsigned* MISC = (volatile LAS unsigned*)(lds + MISC_OFF);
    const int tid = threadIdx.x, lane = tid & 63, wave = __builtin_amdgcn_readfirstlane(tid >> 6);
    const int G = gridDim.x; const int bx = blockIdx.x; const int vcu = (G % 8 == 0) ? (bx % 8) * (G / 8) + bx / 8 : bx;
    const int gw = vcu * NWAVES + wave, NGW = G * NWAVES;
    unsigned char* ws = args.ws;
    gu32* ctl = (gu32*)(ws + WS_CTL);
    const float* x = args.in[0];
    bf16_t* WinT = (bf16_t*)(ws + WS_WIN); bf16_t* WoutT = (bf16_t*)(ws + WS_WOUT); bf16_t* WpgT = (bf16_t*)(ws + WS_WPG); bf16_t* WppT = (bf16_t*)(ws + WS_WPP);
    bf16_t* WguT = (bf16_t*)(ws + WS_WGU); bf16_t* WdnT = (bf16_t*)(ws + WS_WDN);
    bf16_t* XN = (bf16_t*)(ws + WS_XN); bf16_t* ZB = (bf16_t*)(ws + WS_ZB); bf16_t* MIXB = (bf16_t*)(ws + WS_MIXB); bf16_t* PB = (bf16_t*)(ws + WS_PB);
    bf16_t* X1H = (bf16_t*)(ws + WS_X1); bf16_t* X1L = (bf16_t*)(ws + WS_X1 + 64 * MiB); bf16_t* X1B = (bf16_t*)(ws + WS_X1B);
    for (int u = tid; u < 1024; u += NWAVES * 64) ((LAS unsigned*)(lds + MISC_OFF))[u] = 0u;
    __syncthreads();
    const int lo = args.ph_lo, hi = args.ph_hi;
    XcdBarrier bar; bar.bar = (unsigned*)(ctl + CW_BAR) + args.li * XCD_BAR_WORDS; bar.x = 0; bar.st = nullptr;
    if (hi - lo > 1) bar = xcd_barrier_post((unsigned*)(ctl + CW_BAR) + args.li * XCD_BAR_WORDS, MISC + MI_BAR);
#ifndef NGEMM_SPLIT
#define NGEMM_SPLIT 128
#endif
#ifndef GEMM_ROUNDS
#define GEMM_ROUNDS 11
#endif
#ifndef PHMASK
#define PHMASK 0xfff
#endif
#define IN(k) (((PHMASK >> (k)) & 1) && lo <= (k) && (k) < hi)
#define BOTH(k) (IN(k) && IN((k) + 1))

    constexpr int I_IN = 32 * 96, I_OUT = 32 * 32, I_PG = 32 * 32, I_PP = 4 * 32, I_GU1 = 32 * 64, I_DN1 = 32 * 32;
    constexpr int NITEMS_B = I_OUT + I_PG + I_PP + NE * I_GU1 + NE * I_DN1;
#define PROLOGUE_B(gwb, ngwb) do { \
        LAS unsigned* scr = (LAS unsigned*)(lds + RING_OFF + wave * 16384); \
        EXPERTS_B(gwb, ngwb); \
        for (int it = (gwb); it < I_OUT + I_PG + I_PP; it += (ngwb)) { int r = it; \
            if (r < I_OUT) { if (!OUT_FP8) cvt_tile<0>(args.in[10], D, D, 64 * (r / 32), 64 * (r % 32), WoutT, nullptr, scr, lane); continue; } r -= I_OUT; \
            if (r < I_PG) { if (!MOE_FP8) cvt_tile<0>(args.in[19], D, D, 64 * (r / 32), 64 * (r % 32), WpgT, args.in[18], scr, lane); continue; } r -= I_PG; \
            cvt_tile<0>(args.in[20], D, PLE, 64 * (r / 32), 64 * (r % 32), WppT, nullptr, scr, lane); } \
        for (int m = (gwb); m < T; m += (ngwb)) { const f32x4 v = *((const f32x4*)(args.in[1] + (size_t)m * PLE) + lane); u32x2 w; w.x = cvt_pk_bf16(v[0], v[1]); w.y = cvt_pk_bf16(v[2], v[3]); *((u32x2*)(PB + (size_t)m * PLE) + lane) = w; } \
        { bf16_t* wr_hi = (bf16_t*)(ws + WS_WR); bf16_t* wr_lo = wr_hi + NE * D; \
          for (int i = ((gwb) * 64 + lane); i < NE * D; i += (ngwb) * 64) { const int e = i / D, k = i % D; const float v = args.in[12][(size_t)k * NE + e] * args.in[11][k]; const unsigned short hb = f2bf(v); wr_hi[i] = hb; wr_lo[i] = f2bf(v - bf2f(hb)); } } \
    } while (0)
#if MOE_FP8
#define EXPERTS_B(gwb, ngwb) do { LAS float* sct = (LAS float*)(lds + RING_BYTES);     \
        for (int k = tid; k < D; k += NWAVES * 64) { sct[k] = args.in[11][k] * F8_WSCALE; sct[D + k] = args.in[18][k] * F8_WSCALE; } \
        __syncthreads(); \
        f8_convert_experts<1>(args.in[14], NE, D, 2 * DFF, (unsigned char*)WguT, sct, F8_WSCALE, (gwb), (ngwb), scr, lane); \
        f8_convert_experts<0>(args.in[16], NE, DFF, D, (unsigned char*)WdnT, nullptr, F8_WSCALE, (gwb), (ngwb), scr, lane); \
        f8_convert_experts<0>(args.in[19], 1, D, D, (unsigned char*)WpgT, sct + D, F8_WSCALE, (gwb), (ngwb), scr, lane); \
        if (OUT_FP8) f8_convert_experts<0>(args.in[10], 1, D, D, (unsigned char*)WoutT, nullptr, F8_WSCALE, (gwb), (ngwb), scr, lane); } while (0)
#else
#define EXPERTS_B(gwb, ngwb) do { for (int it = (gwb); it < NE * (I_GU1 + I_DN1); it += (ngwb)) { int r = it; \
            if (r < NE * I_GU1) { const int e = r / I_GU1, q = r % I_GU1; CVT_GU(e, q); continue; } r -= NE * I_GU1; \
            { const int e = r / I_DN1, q = r % I_DN1; CVT_DN(e, q); } } } while (0)
#endif
#if MOE_FP8
#define CVT_GU(e, q) cvt_tile_f8<1>(args.in[14] + (size_t)(e) * D * 2 * DFF, 2 * DFF, D, 64 * ((q) / 64), 64 * ((q) % 64), (unsigned char*)WguT + (size_t)(e) * 2 * DFF * D, args.in[11], F8_WSCALE, scr, lane)
#define CVT_DN(e, q) cvt_tile_f8<0>(args.in[16] + (size_t)(e) * DFF * D, D, DFF, 64 * ((q) / 32), 64 * ((q) % 32), (unsigned char*)WdnT + (size_t)(e) * D * DFF, nullptr, F8_WSCALE, scr, lane)
#else
#define CVT_GU(e, q) cvt_tile<1>(args.in[14] + (size_t)(e) * D * 2 * DFF, 2 * DFF, D, 64 * ((q) / 64), 64 * ((q) % 64), WguT + (size_t)(e) * 2 * DFF * D, args.in[11], scr, lane)
#define CVT_DN(e, q) cvt_tile<0>(args.in[16] + (size_t)(e) * DFF * D, D, DFF, 64 * ((q) / 32), 64 * ((q) % 32), WdnT + (size_t)(e) * D * DFF, nullptr, scr, lane)
#endif
    const int NGEMM = (G == 256) ? NGEMM_SPLIT : G;
    if (IN(0)) {
        LAS unsigned* scr = (LAS unsigned*)(lds + RING_OFF + wave * 16384);
        for (int it = gw; it < I_IN; it += NGW) cvt_tile<0>(args.in[3], IN_W, D, 64 * (it / 96), 64 * (it % 96), WinT, nullptr, scr, lane);
        {
            const f32x4* gr = (const f32x4*)args.in[2] + lane;
            f32x4 vn[8];
            if (gw < T) {
#pragma unroll
                for (int j = 0; j < 8; ++j) vn[j] = NTLD(4, (const f32x4*)(x + (size_t)gw * D) + lane + 64 * j); }
            for (int m = gw; m < T; m += NGW) {
                f32x4 v[8]; float s = 0.f;
#pragma unroll
                for (int j = 0; j < 8; ++j) { v[j] = vn[j]; s += (v[j][0] * v[j][0] + v[j][1] * v[j][1]) + (v[j][2] * v[j][2] + v[j][3] * v[j][3]); }
                if (m + NGW < T) {
#pragma unroll
                    for (int j = 0; j < 8; ++j) vn[j] = NTLD(4, (const f32x4*)(x + (size_t)(m + NGW) * D) + lane + 64 * j); }
                const float rr = rsqrtf(wave_sum(s) * (1.f / D) + RMS_EPS);
                u32x2* o8 = (u32x2*)(XN + (size_t)m * D) + lane;
#pragma unroll
                for (int j = 0; j < 8; ++j) { const f32x4 gg = gr[64 * j]; u32x2 w; w.x = cvt_pk_bf16(v[j][0] * rr * gg[0], v[j][1] * rr * gg[1]); w.y = cvt_pk_bf16(v[j][2] * rr * gg[2], v[j][3] * rr * gg[3]); o8[64 * j] = w; }
            }
        }
        if (!IN(1) || NGEMM == G) PROLOGUE_B(gw, NGW);
        if (BOTH(0)) xcd_barrier(bar);
    }
    if (IN(1)) {
        const bool split = (NGEMM != G) && IN(0);
        if (split && bx >= NGEMM) { PROLOGUE_B((bx - NGEMM) * NWAVES + wave, (G - NGEMM) * NWAVES); __syncthreads(); }
        {
            pg8::Gemm g{XN, WinT, nullptr, 0, D, 0}; pg8::StaticOrder S;
            if (!split) S.init(T, IN_W, G, bx); else if (bx < NGEMM) S.init(T, IN_W, NGEMM, bx, 0, GEMM_ROUNDS); else S.init(T, IN_W, G - NGEMM, bx - NGEMM, GEMM_ROUNDS * NGEMM / (G - NGEMM));
            pg8::EpiBf16 E{ZB, IN_W};
            pg8::gemm_phase<pg8::EpiBf16, pg8::StaticOrder, false>(lds + RING_OFF, g, S, E);
        }
        if (BOTH(1)) xcd_barrier(bar);
    }

    if (IN(2)) {
        LAS unsigned char* STb = lds;
        LAS unsigned char* QBl = lds + 34816;
        LAS unsigned char* QRl = lds + 52224;
        LAS unsigned char* KBl = lds + 69632;
        LAS unsigned char* KBLT = lds + 87040;
        LAS unsigned char* VT = lds + 105472;
        LAS unsigned char* PL = lds + 123904;
        LAS float* tot = (LAS float*)(lds + 133120);
        LAS float* dec = (LAS float*)(lds + 135168);
        bf16_t* OL = (bf16_t*)(ws + WS_HG)  ; bf16_t* QBF = (bf16_t*)(ws + WS_HG + 64 * MiB); float* SL = (float*)(ws + WS_HG + 96 * MiB); float* DL = (float*)(ws + WS_HG + 128 * MiB);
        const int d = tid & 127, q = tid >> 7, fr = lane & 15, fq = lane >> 4, tm = wave >> 1, eh = wave & 1;
        u32x4 pq[2], pf[2], pv[2];
#define P2_LOAD(U, C) do { const int _bh = (U) >> 4, _sc = (U) & 15, _b = _bh >> 3, _h = _bh & 7, _tc = _b * SEQ + _sc * 256 + 64 * (C); \
            _Pragma("unroll") for (int i = 0; i < 2; ++i) { const bf16_t* zr = ZB + (size_t)(_tc + (tid >> 4) + 32 * i) * IN_W + _h * 128 + (tid & 15) * 8; pq[i] = NTLD(3, (const u32x4*)(zr + ZQ)); pf[i] = NTLD(3, (const u32x4*)(zr + ZF)); pv[i] = NTLD(3, (const u32x4*)(zr + ZI)); } } while (0)
        if (bx < BATCH * HG_H * 16) P2_LOAD(bx, 0);
        for (int unit = bx; unit < BATCH * HG_H * 16; unit += G) {
            const int bh = unit >> 4, sc = unit & 15, b = bh >> 3, h = bh & 7, t_base = b * SEQ + sc * 256;
            const float l0 = args.in[4][h * 128 + d], l1 = args.in[4][HG_K + h * 128 + d]; const float lbv = 1.f / (1.f + expf(l1 - l0));
            f32x4 sacc[8];
#pragma unroll
            for (int i = 0; i < 8; ++i) sacc[i] = (f32x4){0.f, 0.f, 0.f, 0.f};
            float Bcum = 0.f;
            const int rw0 = tid >> 4, rch = tid & 15;
            LAS unsigned char* RAWQ = lds + 34816; LAS unsigned char* RAWF = lds + 51200; LAS unsigned char* RAWV = lds + 67584;
            for (int c = 0; c < 4; ++c) {
                const int tc = t_base + 64 * c;
#pragma unroll
                for (int i = 0; i < 2; ++i) { *(LAS u32x4*)(RAWQ + (rw0 + 32 * i) * 256 + rch * 16) = pq[i]; *(LAS u32x4*)(RAWF + (rw0 + 32 * i) * 256 + rch * 16) = pf[i]; *(LAS u32x4*)(RAWV + (rw0 + 32 * i) * 256 + rch * 16) = pv[i]; }
                __syncthreads();
                unsigned short qr[16], fr_[16], vr[16];
#pragma unroll
                for (int i = 0; i < 16; ++i) { qr[i] = *(const LAS unsigned short*)(RAWQ + (16 * q + i) * 256 + d * 2); fr_[i] = *(const LAS unsigned short*)(RAWF + (16 * q + i) * 256 + d * 2); vr[i] = *(const LAS unsigned short*)(RAWV + (16 * q + i) * 256 + d * 2); }
                float bl[16], qs[16], kk[16]; float run = 0.f;
#pragma unroll
                for (int i = 0; i < 16; ++i) { const float qf = bf2f(qr[i]); qs[i] = qf * fast_sigmoid(qf); const float f = lbv + (1.f - lbv) * fast_sigmoid(bf2f(fr_[i])); kk[i] = 1.f - f; run += fast_log(f); bl[i] = run; }
                tot[q * 128 + d] = run;
                __syncthreads();
                const float t0 = tot[d], t1 = tot[128 + d], t2 = tot[256 + d], t3 = tot[384 + d];
                const float off = (q > 0 ? t0 : 0.f) + (q > 1 ? t1 : 0.f) + (q > 2 ? t2 : 0.f), blast = (t0 + t1) + (t2 + t3), R = 0.5f * blast;
                unsigned kw[8], vw[8];
#pragma unroll
                for (int i = 0; i < 16; i += 2) {
                    float kb2[2];
#pragma unroll
                    for (int j = 0; j < 2; ++j) { const float bb = bl[i + j] + off; const int tt = 16 * q + i + j;
                        const float eb = fast_exp(bb), qbv = qs[i + j] * eb;
                        *(LAS unsigned short*)(QBl + tt * 272 + d * 2) = f2bf(qbv);
                        *(LAS unsigned short*)(QRl + tt * 272 + d * 2) = f2bf(qs[i + j] * fast_exp(bb - R));
                        *(LAS unsigned short*)(KBl + tt * 272 + d * 2) = f2bf(kk[i + j] * fast_exp(R - bb));
                        QBF[(size_t)(tc + tt) * HG_K + h * 128 + d] = f2bf(qs[i + j] * fast_exp(Bcum + bb));
                        kb2[j] = kk[i + j] * fast_exp(blast - bb); }
                    kw[i >> 1] = cvt_pk_bf16(kb2[0], kb2[1]); vw[i >> 1] = (unsigned)vr[i] | ((unsigned)vr[i + 1] << 16);
                }
                *(LAS u32x4*)(KBLT + d * 144 + q * 32) = (u32x4){kw[0], kw[1], kw[2], kw[3]}; *(LAS u32x4*)(KBLT + d * 144 + q * 32 + 16) = (u32x4){kw[4], kw[5], kw[6], kw[7]};
                *(LAS u32x4*)(VT + d * 144 + q * 32) = (u32x4){vw[0], vw[1], vw[2], vw[3]}; *(LAS u32x4*)(VT + d * 144 + q * 32 + 16) = (u32x4){vw[4], vw[5], vw[6], vw[7]};
                if (q == 0) dec[d] = fast_exp(blast);
                Bcum += blast;
                if (c < 3) P2_LOAD(unit, c + 1);
                else if (unit + G < BATCH * HG_H * 16) P2_LOAD(unit + G, 0);
                __syncthreads();
#pragma unroll
                for (int si = 0; si < 2; ++si) { const int ts = 2 * eh + si; u32x2 pw = (u32x2){0u, 0u};
                    if (ts <= tm) { f32x4 a4 = (f32x4){0.f, 0.f, 0.f, 0.f};
#pragma unroll
                        for (int ks = 0; ks < 4; ++ks) { const bf16x8 af = *(const LAS bf16x8*)(KBl + (ts * 16 + fr) * 272 + (32 * ks + 8 * fq) * 2), bfv = *(const LAS bf16x8*)(QRl + (tm * 16 + fr) * 272 + (32 * ks + 8 * fq) * 2);
                            a4 = __builtin_amdgcn_mfma_f32_16x16x32_bf16(af, bfv, a4, 0, 0, 0); }
                        const int tt = tm * 16 + fr, s0 = ts * 16 + 4 * fq;
                        pw.x = cvt_pk_bf16(s0 + 0 <= tt ? a4[0] : 0.f, s0 + 1 <= tt ? a4[1] : 0.f); pw.y = cvt_pk_bf16(s0 + 2 <= tt ? a4[2] : 0.f, s0 + 3 <= tt ? a4[3] : 0.f); }
                    *(LAS u32x2*)(PL + (tm * 16 + fr) * 144 + (ts * 16 + 4 * fq) * 2) = pw; }
                f32x4 oacc[4];
#pragma unroll
                for (int et = 0; et < 4; ++et) oacc[et] = (f32x4){0.f, 0.f, 0.f, 0.f};
                if (c > 0) {
#pragma unroll
                    for (int ks = 0; ks < 4; ++ks) { const bf16x8 bfv = *(const LAS bf16x8*)(QBl + (tm * 16 + fr) * 272 + (32 * ks + 8 * fq) * 2);
#pragma unroll
                        for (int et = 0; et < 4; ++et) { const bf16x8 af = *(const LAS bf16x8*)(STb + ((4 * eh + et) * 16 + fr) * 272 + (32 * ks + 8 * fq) * 2);
                            oacc[et] = __builtin_amdgcn_mfma_f32_16x16x32_bf16(af, bfv, oacc[et], 0, 0, 0); } }
                }
                __syncthreads();
#pragma unroll
                for (int ks = 0; ks < 2; ++ks) if (32 * ks <= 16 * tm + 15) { const bf16x8 bfv = *(const LAS bf16x8*)(PL + (tm * 16 + fr) * 144 + (32 * ks + 8 * fq) * 2);
#pragma unroll
                    for (int et = 0; et < 4; ++et) { const bf16x8 af = *(const LAS bf16x8*)(VT + ((4 * eh + et) * 16 + fr) * 144 + (32 * ks + 8 * fq) * 2);
                        oacc[et] = __builtin_amdgcn_mfma_f32_16x16x32_bf16(af, bfv, oacc[et], 0, 0, 0); } }
#pragma unroll
                for (int et = 0; et < 4; ++et) { u32x2 w; w.x = cvt_pk_bf16(oacc[et][0], oacc[et][1]); w.y = cvt_pk_bf16(oacc[et][2], oacc[et][3]); *(u32x2*)(OL + (size_t)(tc + tm * 16 + fr) * HG_V + h * 128 + (4 * eh + et) * 16 + 4 * fq) = w; }
#pragma unroll
                for (int dt = 0; dt < 8; ++dt) { const f32x4 dv = *(const LAS f32x4*)(dec + 16 * dt + 4 * fq); sacc[dt] = sacc[dt] * dv;
#pragma unroll
                    for (int ks = 0; ks < 2; ++ks) { const bf16x8 af = *(const LAS bf16x8*)(KBLT + (dt * 16 + fr) * 144 + (32 * ks + 8 * fq) * 2), bfv = *(const LAS bf16x8*)(VT + (wave * 16 + fr) * 144 + (32 * ks + 8 * fq) * 2);
                        sacc[dt] = __builtin_amdgcn_mfma_f32_16x16x32_bf16(af, bfv, sacc[dt], 0, 0, 0); }
                    if (c < 3) { u32x2 w; w.x = cvt_pk_bf16(sacc[dt][0], sacc[dt][1]); w.y = cvt_pk_bf16(sacc[dt][2], sacc[dt][3]); *(LAS u32x2*)(STb + (wave * 16 + fr) * 272 + (16 * dt + 4 * fq) * 2) = w; } }
            }
#pragma unroll
            for (int dt = 0; dt < 8; ++dt) *(f32x4*)(SL + (size_t)unit * 16384 + (wave * 16 + fr) * 128 + 16 * dt + 4 * fq) = sacc[dt];
            if (q == 0) DL[unit * 128 + d] = fast_exp(Bcum);
            __syncthreads();
        }
        { float* stats = (float*)(ws + WS_HG + 145 * MiB);
          for (int t0 = gw; t0 < T; t0 += 4 * NGW) {
            u32x4 w0a[4], w1a[4];
#pragma unroll
            for (int i = 0; i < 4; ++i) { const int tt = t0 + i * NGW < T ? t0 + i * NGW : T - 1; w0a[i] = *(const u32x4*)(ZB + (size_t)tt * IN_W + ZV + 16 * lane); w1a[i] = *(const u32x4*)(ZB + (size_t)tt * IN_W + ZV + 16 * lane + 8); }
#pragma unroll
            for (int i = 0; i < 4; ++i) { const int t = t0 + i * NGW; const u32x4 w0 = w0a[i], w1 = w1a[i];
            float v[16] = {bflo(w0.x), bfhi(w0.x), bflo(w0.y), bfhi(w0.y), bflo(w0.z), bfhi(w0.z), bflo(w0.w), bfhi(w0.w), bflo(w1.x), bfhi(w1.x), bflo(w1.y), bfhi(w1.y), bflo(w1.z), bfhi(w1.z), bflo(w1.w), bfhi(w1.w)};
            float sm = 0.f;
#pragma unroll
            for (int j = 0; j < 16; ++j) { v[j] = gelu_fast(v[j]); sm += v[j]; }
            const float mu = wave_sum(sm) * (1.f / GM_W); float qq = 0.f;
#pragma unroll
            for (int j = 0; j < 16; ++j) { const float dd = v[j] - mu; qq += dd * dd; }
            const float rs = rsqrtf(wave_sum(qq) * (1.f / GM_W) + LN_EPS);
            if (lane == 0 && t < T) { stats[2 * t] = mu; stats[2 * t + 1] = rs; } } } }
        if (BOTH(2)) xcd_barrier(bar);
    }
    if (IN(3)) {
        const float* SL = (const float*)(ws + WS_HG + 96 * MiB); const float* DL = (const float*)(ws + WS_HG + 128 * MiB); bf16_t* SINb = (bf16_t*)(ws + WS_HG + 129 * MiB);
        for (int item = bx; item < BATCH * HG_H * 8; item += G) {
            const int bh = item >> 3, sl = item & 7; const int eo = sl * 2048 + tid * 4;
            f32x4 st = (f32x4){0.f, 0.f, 0.f, 0.f};
#pragma unroll
            for (int sc = 0; sc < 15; ++sc) { const int unit = bh * 16 + sc;
                const f32x4 sl4 = *(const f32x4*)(SL + (size_t)unit * 16384 + eo), dv = *(const f32x4*)(DL + unit * 128 + (eo & 127));
                st = st * dv + sl4;
                u32x2 w; w.x = cvt_pk_bf16(st[0], st[1]); w.y = cvt_pk_bf16(st[2], st[3]); *(u32x2*)(SINb + (size_t)(unit + 1) * 16384 + eo) = w; }
        }
        if (BOTH(3)) xcd_barrier(bar);
    }
    if (IN(4)) {
        const bf16_t* OL = (const bf16_t*)(ws + WS_HG); const bf16_t* QBF = (const bf16_t*)(ws + WS_HG + 64 * MiB); const bf16_t* SINb = (const bf16_t*)(ws + WS_HG + 129 * MiB);
        const int fr = lane & 15, fq = lane >> 4;
        const int NFX = BATCH * HG_H * 32;
        LAS unsigned char* STL = lds;
        u32x4 spf[4]; u32x2 olw[8], ogw[8]; bf16x8 qbw[4];
#define FX_LOAD(U) do { const int _bh = (U) >> 5, _blk = (U) & 31, _b = _bh >> 3, _h = _bh & 7, _sc = _blk >> 1; const int _t = _b * SEQ + _blk * 128 + wave * 16 + fr; \
            _Pragma("unroll") for (int et = 0; et < 8; ++et) { olw[et] = NTLD(2, (const u32x2*)(OL + (size_t)_t * HG_V + _h * 128 + et * 16 + 4 * fq)); ogw[et] = NTLD(2, (const u32x2*)(ZB + (size_t)_t * IN_W + ZG + _h * 128 + et * 16 + 4 * fq)); } \
            if (_sc > 0) { const unsigned char* _sp = (const unsigned char*)(SINb + (size_t)(_bh * 16 + _sc) * 16384) + tid * 16; \
                _Pragma("unroll") for (int ks = 0; ks < 4; ++ks) qbw[ks] = NTLD(2, (const bf16x8*)(QBF + (size_t)_t * HG_K + _h * 128 + 32 * ks + 8 * fq)); \
                _Pragma("unroll") for (int j = 0; j < 4; ++j) spf[j] = *(const u32x4*)(_sp + j * 8192); } } while (0)
#ifdef P4_SKIP
        if (!(args.li > 0 && P4_SKIP == 1))
#endif
        {
        if (bx < NFX) FX_LOAD(bx);
        for (int unit = bx; unit < NFX; unit += G) {
            const int bh = unit >> 5, blk = unit & 31, b = bh >> 3, h = bh & 7, sc = blk >> 1;
            const int t = b * SEQ + blk * 128 + wave * 16 + fr;
            f32x4 acc[8]; u32x2 ogv[8]; bf16x8 qbc[4];
#pragma unroll
            for (int et = 0; et < 8; ++et) { const u32x2 ow = olw[et]; acc[et] = (f32x4){bflo(ow.x), bfhi(ow.x), bflo(ow.y), bfhi(ow.y)}; ogv[et] = ogw[et]; }
            if (sc > 0) {
#pragma unroll
                for (int ks = 0; ks < 4; ++ks) qbc[ks] = qbw[ks];
#pragma unroll
                for (int j = 0; j < 4; ++j) *(LAS u32x4*)(STL + ((tid >> 4) + 32 * j) * 272 + (tid & 15) * 16) = spf[j]; }
            __syncthreads();
            if (unit + G < NFX) FX_LOAD(unit + G);
            if (sc > 0) {
#pragma unroll
                for (int ks = 0; ks < 4; ++ks) {
#pragma unroll
                    for (int et = 0; et < 8; ++et) { const bf16x8 af = *(const LAS bf16x8*)(STL + (et * 16 + fr) * 272 + (32 * ks + 8 * fq) * 2);
                        acc[et] = __builtin_amdgcn_mfma_f32_16x16x32_bf16(af, qbc[ks], acc[et], 0, 0, 0); } } }
            float ss = 0.f;
#pragma unroll
            for (int et = 0; et < 8; ++et) ss += (acc[et][0] * acc[et][0] + acc[et][1] * acc[et][1]) + (acc[et][2] * acc[et][2] + acc[et][3] * acc[et][3]);
            ss += __shfl_xor(ss, 16); ss += __shfl_xor(ss, 32);
            const float rr = rsqrtf(ss * (1.f / 128.f) + RMS_EPS);
#pragma unroll
            for (int et = 0; et < 8; ++et) { const int e0 = h * 128 + et * 16 + 4 * fq;
                const f32x4 gn = *(const f32x4*)(args.in[5] + e0); const u32x2 og = ogv[et];
                const float m0 = acc[et][0] * rr * gn[0] * fast_sigmoid(bflo(og.x)), m1 = acc[et][1] * rr * gn[1] * fast_sigmoid(bfhi(og.x)), m2 = acc[et][2] * rr * gn[2] * fast_sigmoid(bflo(og.y)), m3 = acc[et][3] * rr * gn[3] * fast_sigmoid(bfhi(og.y));
#if OUT_FP8
                *(unsigned*)((unsigned char*)MIXB + (size_t)t * D + e0) = pack4_fp8c(m0 * F8_MSCALE, m1 * F8_MSCALE, m2 * F8_MSCALE, m3 * F8_MSCALE); }
#else
                u32x2 w; w.x = cvt_pk_bf16(m0, m1); w.y = cvt_pk_bf16(m2, m3);
                *(u32x2*)(MIXB + (size_t)t * D + e0) = w; }
#endif
            __syncthreads();
        }
        }
#undef FX_LOAD
#ifdef P4_SKIP
        if (!(args.li > 0 && P4_SKIP == 2))
#endif
        {
            LAS unsigned char* VNT = lds;
            LAS unsigned char* WL = lds + 34816;
            const float* stats = (const float*)(ws + WS_HG + 145 * MiB);
            __syncthreads();
            const int NSP = BATCH * 32 * GM_G;
            LAS float* sst = (LAS float*)(lds + 69632);
            const int c8 = tid & 15, sr = tid >> 4, tw = tid >> 2, seg = tid & 3;
            u32x4 vraw[4]; u32x2 uw[8], uwn[8]; float sstv = 0.f;
            f32x4 lg0 = (f32x4){0.f, 0.f, 0.f, 0.f}, lg1 = lg0, lb0 = lg0, lb1 = lg0; float bsv = 0.f; int wl_g = -1;
#define SP_LOAD(U, UW) do { const int _g = (U) & 7, _tb = ((U) >> 3) * 128; \
                _Pragma("unroll") for (int i = 0; i < 4; ++i) vraw[i] = NTLD(2, (const u32x4*)(ZB + (size_t)(_tb + 4 * sr + i) * IN_W + ZV + _g * 128 + 8 * c8)); \
                _Pragma("unroll") for (int ct = 0; ct < 8; ++ct) UW[ct] = NTLD(2, (const u32x2*)(ZB + (size_t)(_tb + 16 * wave + fr) * IN_W + ZU + _g * 128 + 16 * ct + 4 * fq)); \
                if (tid < 256) sstv = ld_agent_f(stats + 2 * _tb + tid); } while (0)
            if (bx < NSP) SP_LOAD(bx, uw);
            for (int unit = bx; unit < NSP; unit += G) {
                const int g = unit & 7, tb = (unit >> 3) * 128;
                const bool newg = (g != wl_g);
                f32x4 w4[8];
                if (newg) { const float* wp = args.in[8] + ((size_t)g * 128 + tw) * 128 + 32 * seg;
#pragma unroll
                    for (int j = 0; j < 8; ++j) w4[j] = *(const f32x4*)(wp + 4 * j);
                    lg0 = *(const f32x4*)(args.in[6] + g * 128 + 8 * c8); lg1 = *(const f32x4*)(args.in[6] + g * 128 + 8 * c8 + 4); lb0 = *(const f32x4*)(args.in[7] + g * 128 + 8 * c8); lb1 = *(const f32x4*)(args.in[7] + g * 128 + 8 * c8 + 4);
                    bsv = args.in[9][g * 128 + 16 * wave + fr]; }
                if (tid < 256) sst[tid] = sstv;
                __syncthreads();
                { const float lgv[8] = {lg0[0], lg0[1], lg0[2], lg0[3], lg1[0], lg1[1], lg1[2], lg1[3]}, lbv8[8] = {lb0[0], lb0[1], lb0[2], lb0[3], lb1[0], lb1[1], lb1[2], lb1[3]};
                  float vn4[4][8];
#pragma unroll
                  for (int i = 0; i < 4; ++i) { const f32x2 st = *(const LAS f32x2*)(sst + 2 * (4 * sr + i)); const u32x4 w = vraw[i];
                      const float rv[8] = {bflo(w.x), bfhi(w.x), bflo(w.y), bfhi(w.y), bflo(w.z), bfhi(w.z), bflo(w.w), bfhi(w.w)};
#pragma unroll
                      for (int j = 0; j < 8; ++j) vn4[i][j] = (gelu_fast(rv[j]) - st[0]) * st[1] * lgv[j] + lbv8[j]; }
#pragma unroll
                  for (int j = 0; j < 8; ++j) { u32x2 w; w.x = cvt_pk_bf16(vn4[0][j], vn4[1][j]); w.y = cvt_pk_bf16(vn4[2][j], vn4[3][j]); *(LAS u32x2*)(VNT + (8 * c8 + j) * 272 + 8 * sr) = w; } }
                if (newg) { unsigned pk[16];
#pragma unroll
                  for (int j = 0; j < 8; ++j) { const int s0 = 32 * seg + 4 * j;
                      pk[2 * j] = cvt_pk_bf16(s0 <= tw ? w4[j][0] : 0.f, s0 + 1 <= tw ? w4[j][1] : 0.f); pk[2 * j + 1] = cvt_pk_bf16(s0 + 2 <= tw ? w4[j][2] : 0.f, s0 + 3 <= tw ? w4[j][3] : 0.f); }
#pragma unroll
                  for (int j = 0; j < 4; ++j) *(LAS u32x4*)(WL + tw * 272 + seg * 64 + j * 16) = (u32x4){pk[4 * j], pk[4 * j + 1], pk[4 * j + 2], pk[4 * j + 3]};
                  wl_g = g; }
                if (unit + G < NSP) SP_LOAD(unit + G, uwn);
                __syncthreads();
                f32x4 acc[8];
#pragma unroll
                for (int ct = 0; ct < 8; ++ct) acc[ct] = (f32x4){0.f, 0.f, 0.f, 0.f};
                for (int ks = 0; ks <= (16 * wave + 15) >> 5; ++ks) { const bf16x8 bfv = *(const LAS bf16x8*)(WL + (16 * wave + fr) * 272 + (32 * ks + 8 * fq) * 2);
#pragma unroll
                    for (int ct = 0; ct < 8; ++ct) { const bf16x8 af = *(const LAS bf16x8*)(VNT + (16 * ct + fr) * 272 + (32 * ks + 8 * fq) * 2);
                        acc[ct] = __builtin_amdgcn_mfma_f32_16x16x32_bf16(af, bfv, acc[ct], 0, 0, 0); } }
                const int t = tb + 16 * wave + fr;
#pragma unroll
                for (int ct = 0; ct < 8; ++ct) { const int c0 = g * 128 + 16 * ct + 4 * fq;
                    const float m0 = gelu_fast(bflo(uw[ct].x)) * (acc[ct][0] + bsv), m1 = gelu_fast(bfhi(uw[ct].x)) * (acc[ct][1] + bsv), m2 = gelu_fast(bflo(uw[ct].y)) * (acc[ct][2] + bsv), m3 = gelu_fast(bfhi(uw[ct].y)) * (acc[ct][3] + bsv);
#if OUT_FP8
                    *(unsigned*)((unsigned char*)MIXB + (size_t)t * D + 1024 + c0) = pack4_fp8c(m0 * F8_MSCALE, m1 * F8_MSCALE, m2 * F8_MSCALE, m3 * F8_MSCALE); }
#else
                    u32x2 w; w.x = cvt_pk_bf16(m0, m1); w.y = cvt_pk_bf16(m2, m3);
                    *(u32x2*)(MIXB + (size_t)t * D + 1024 + c0) = w; }
#endif
#pragma unroll
                for (int ct = 0; ct < 8; ++ct) uw[ct] = uwn[ct];
                __syncthreads();
            }
#undef SP_LOAD
        }
    }
    if (IN(5)) {
        pg8::Gemm g{MIXB, WoutT, nullptr, 0, D / (OUT_FP8 ? 2 : 1), 0}; pg8::StaticOrder S; S.init(T, D, G, bx);
        pg8::EpiResF32Bf16 E{x, X1H, X1L, X1B};
        const bool seam = BOTH(4);
        auto pre = [&]() { if (seam) xcd_barrier(bar); };
        pg8::gemm_phase<pg8::EpiResF32Bf16, pg8::StaticOrder, false, OUT_FP8 != 0, decltype(pre)>(lds + RING_OFF, g, S, E, pre);
        if (BOTH(5)) xcd_barrier(bar);
    }

    if (IN(6)) {
        typedef float f32x16 __attribute__((ext_vector_type(16)));
        const bf16_t* wr_hi = (const bf16_t*)(ws + WS_WR); const bf16_t* wr_lo = wr_hi + NE * D;
        int* cntg = (int*)(ctl + CW_CNT);
        int* list = (int*)(ws + WS_LIST); float* rsl = (float*)(ws + WS_LIST + 2 * MiB); float* gtl = (float*)(ws + WS_LIST + 4 * MiB);
        int* tok_e = (int*)(ws + WS_TOK); int* tok_p = tok_e + T * 4; float* tok_g = (float*)(tok_p + T * 4);
        LAS float* part = (LAS float*)(lds + RING_OFF);
        LAS float* ssqp = (LAS float*)(lds + RING_OFF + 36864);
        LAS float* lgt = (LAS float*)(lds + RING_OFF + 40960);
        LAS int* hist = (LAS int*)(lds + RING_OFF + 53248);
        const int tg = wave >> 2, kq = wave & 3, r = lane & 31, h = lane >> 5;
        for (int grp = bx; grp < T / 64; grp += G) {
            const int t0 = grp * 64;
            if (tid < 64) hist[tid] = 0;
            f32x16 acc;
#pragma unroll
            for (int i = 0; i < 16; ++i) acc[i] = 0.f;
            const bf16_t* xhp = X1H + (size_t)(t0 + tg * 32 + r) * D + kq * 512 + 8 * h; const bf16_t* xlp = X1L + (size_t)(t0 + tg * 32 + r) * D + kq * 512 + 8 * h;
            const bf16_t* whp = wr_hi + (size_t)r * D + kq * 512 + 8 * h; const bf16_t* wlp = wr_lo + (size_t)r * D + kq * 512 + 8 * h;
            float ss = 0.f;
#pragma unroll 8
            for (int s = 0; s < 32; ++s) {
                const bf16x8 xh = *(const bf16x8*)(xhp + 16 * s); bf16x8 xl = xh; if (X1_LO) xl = *(const bf16x8*)(xlp + 16 * s);
                const bf16x8 wh = *(const bf16x8*)(whp + 16 * s), wl = *(const bf16x8*)(wlp + 16 * s);
#pragma unroll
                for (int j = 0; j < 8; ++j) { const float xv = bf2f((unsigned short)xh[j]) + (X1_LO ? bf2f((unsigned short)xl[j]) : 0.f); ss += xv * xv; }
                acc = __builtin_amdgcn_mfma_f32_32x32x16_bf16(wh, xh, acc, 0, 0, 0);
                if (X1_LO) acc = __builtin_amdgcn_mfma_f32_32x32x16_bf16(wh, xl, acc, 0, 0, 0);
                acc = __builtin_amdgcn_mfma_f32_32x32x16_bf16(wl, xh, acc, 0, 0, 0);
            }
            ss += __shfl_xor(ss, 32);
            if (h == 0) ssqp[(tg * 4 + kq) * 32 + r] = ss;
#pragma unroll
            for (int i = 0; i < 16; ++i) part[((tg * 4 + kq) * 32 + r) * 33 + (i & 3) + 8 * (i >> 2) + 4 * h] = acc[i];
            __syncthreads();
            {
                const int tk = lane, tgg = tk >> 5, rr = tk & 31;
                const float sq = ssqp[(tgg * 4 + 0) * 32 + rr] + ssqp[(tgg * 4 + 1) * 32 + rr] + ssqp[(tgg * 4 + 2) * 32 + rr] + ssqp[(tgg * 4 + 3) * 32 + rr];
                const float rstd = rsqrtf(sq * (1.f / D) + RMS_EPS);
#pragma unroll
                for (int j = 0; j < 4; ++j) { const int e = wave * 4 + j;
                    const float v = part[((tgg * 4 + 0) * 32 + rr) * 33 + e] + part[((tgg * 4 + 1) * 32 + rr) * 33 + e] + part[((tgg * 4 + 2) * 32 + rr) * 33 + e] + part[((tgg * 4 + 3) * 32 + rr) * 33 + e];
                    lgt[tk * 33 + e] = v * rstd + args.in[13][e]; }
                if (wave == 0) lgt[tk * 33 + 32] = rstd;
            }
            __syncthreads();
            if (wave == 0) {
                const int t = t0 + lane;
                float lv[32];
#pragma unroll
                for (int e = 0; e < 32; ++e) lv[e] = lgt[lane * 33 + e];
                const float rstd = lgt[lane * 33 + 32];
                float tv[4]; int ti[4];
#pragma unroll
                for (int k = 0; k < 4; ++k) { float bv = lv[0]; int bi = 0;
#pragma unroll
                    for (int e = 1; e < 32; ++e) if (lv[e] > bv) { bv = lv[e]; bi = e; }
                    tv[k] = bv; ti[k] = bi;
#pragma unroll
                    for (int e = 0; e < 32; ++e) if (e == bi) lv[e] = -INFINITY; }
                const float e1 = expf(tv[1] - tv[0]), e2 = expf(tv[2] - tv[0]), e3 = expf(tv[3] - tv[0]); const float inv = 1.f / (1.f + e1 + e2 + e3);
                const float gk[4] = {inv, e1 * inv, e2 * inv, e3 * inv};
                int rk[4];
#pragma unroll
                for (int k = 0; k < 4; ++k) rk[k] = __hip_atomic_fetch_add(hist + ti[k], 1, __ATOMIC_RELAXED, __HIP_MEMORY_SCOPE_WORKGROUP);
                LDS_WAIT();
                if (lane < 32) { const int c = hist[lane]; hist[32 + lane] = c > 0 ? atomicAdd(cntg + lane * CNT_STRIDE, c) : 0; }
                LDS_WAIT();
#pragma unroll
                for (int k = 0; k < 4; ++k) { const int e = ti[k], ps = hist[32 + e] + rk[k];
                    list[e * LISTCAP + ps] = t; rsl[e * LISTCAP + ps] = rstd; gtl[e * LISTCAP + ps] = gk[k];
                    tok_e[t * 4 + k] = e; tok_p[t * 4 + k] = ps; tok_g[t * 4 + k] = gk[k]; }
            }
            __syncthreads();
        }
        if (BOTH(6)) xcd_barrier(bar);
    }
#define BUILD_TILE_TABLE() do { \
        if (wave == 0) { const int c = lane < NE ? ((const int*)(ctl + CW_CNT))[lane * CNT_STRIDE] : 0; int nt = (c + 255) >> 8, inc = nt; \
            _Pragma("unroll") for (int o = 1; o < 64; o <<= 1) { const int v = __shfl_up(inc, o); if (lane >= o) inc += v; } \
            if (lane < NE) MISC[MI_TSTART + lane] = (unsigned)(inc - nt); if (lane == NE - 1) { MISC[MI_TSTART + NE] = (unsigned)inc; MISC[MI_NT] = (unsigned)inc; } } \
        __syncthreads(); \
        { const int NTt = (int)MISC[MI_NT]; if (tid < NTt) { int e = 0; _Pragma("unroll") for (int q = 1; q < NE; ++q) e += ((int)MISC[MI_TSTART + q] <= tid) ? 1 : 0; MISC[MI_TILEE + tid] = (unsigned)e; } } \
        __syncthreads(); } while (0)
    if (IN(7)) {
        BUILD_TILE_TABLE();
        pg8::Gemm g{X1B, WguT, (const int*)(ws + WS_LIST), (long long)2 * DFF * D / (MOE_FP8 ? 2 : 1), D / (MOE_FP8 ? 2 : 1), T - 1};
        pg8::MoeOrder S{(int)MISC[MI_NT], 2 * DFF / 256, G, bx, (const LAS int*)(lds + MISC_OFF) + MI_TILEE, (const LAS int*)(lds + MISC_OFF) + MI_TSTART};
        pg8::EpiSwiglu E{(bf16_t*)(ws + WS_ACT), (const float*)(ws + WS_LIST + 2 * MiB), args.in[15]};
        pg8::gemm_phase<pg8::EpiSwiglu, pg8::MoeOrder, true, MOE_FP8 != 0>(lds + RING_OFF, g, S, E);
    }
    if (IN(8)) {
        BUILD_TILE_TABLE();
        pg8::Gemm g{(const bf16_t*)(ws + WS_ACT), WdnT, nullptr, (long long)D * DFF / (MOE_FP8 ? 2 : 1), DFF / (MOE_FP8 ? 2 : 1), 0};
        pg8::MoeOrder S{(int)MISC[MI_NT], D / 256, G, bx, (const LAS int*)(lds + MISC_OFF) + MI_TILEE, (const LAS int*)(lds + MISC_OFF) + MI_TSTART};
        pg8::EpiDown E{(bf16_t*)(ws + WS_Y), (const float*)(ws + WS_LIST + 4 * MiB), args.in[17]};
        const bool seam = BOTH(7); auto pre = [&]() { if (seam) xcd_barrier(bar); };
        pg8::gemm_phase<pg8::EpiDown, pg8::MoeOrder, false, MOE_FP8 != 0, decltype(pre)>(lds + RING_OFF, g, S, E, pre);
        if (BOTH(8)) xcd_barrier(bar);
    }
    if (IN(9)) {
        BUILD_TILE_TABLE();
        const int* tok_e = (const int*)(ws + WS_TOK); const int* tok_p = tok_e + T * 4;
        bf16_t* X2B = (bf16_t*)(ws + WS_X2B); unsigned char* X2F8 = (unsigned char*)(ws + WS_X2); float* rstd2 = (float*)(ws + WS_RSTD);
        for (int tb0 = gw; tb0 < T; tb0 += 8 * NGW) {
          int myrow = 0; { const int tt = tb0 + (lane >> 2) * NGW; if (lane < 32 && tt < T) { const int e = tok_e[tt * 4 + (lane & 3)]; myrow = (int)MISC[MI_TSTART + e] * 256 + tok_p[tt * 4 + (lane & 3)]; } }
          u32x4 nah[4]; u32x2 ny[4][4];
#define CB_LOAD(TI) do { const int _t = tb0 + (TI) * NGW; if (_t < T) { \
              _Pragma("unroll") for (int j = 0; j < 4; ++j) { const size_t c = (size_t)8 * lane + 512 * j; nah[j] = __builtin_nontemporal_load((const u32x4*)(X1H + (size_t)_t * D + c)); \
                  _Pragma("unroll") for (int k = 0; k < 4; ++k) ny[j][k] = __builtin_nontemporal_load((const u32x2*)((const unsigned char*)(ws + WS_Y) + (size_t)__shfl(myrow, (TI) * 4 + k) * D + c)); } } } while (0)
          CB_LOAD(0);
#pragma unroll
          for (int ti = 0; ti < 8; ++ti) { const int t = tb0 + ti * NGW; if (t >= T) break;
            u32x4 ah4[4]; u32x2 yv[4][4];
#pragma unroll
            for (int j = 0; j < 4; ++j) { ah4[j] = nah[j];
#pragma unroll
                for (int k = 0; k < 4; ++k) yv[j][k] = ny[j][k]; }
            if (ti < 7) CB_LOAD(ti + 1);
            float s = 0.f;
#pragma unroll
            for (int j = 0; j < 4; ++j) {
                const size_t c = (size_t)8 * lane + 512 * j;
                const u32x4 ah = ah4[j];
                float v[8] = {bflo(ah.x), bfhi(ah.x), bflo(ah.y), bfhi(ah.y), bflo(ah.z), bfhi(ah.z), bflo(ah.w), bfhi(ah.w)};
                float ys[8] = {0.f, 0.f, 0.f, 0.f, 0.f, 0.f, 0.f, 0.f};
#pragma unroll
                for (int k = 0; k < 4; ++k) { const u32x2 y = yv[j][k]; float lo[4], hi[4]; unpack4_fp8(y.x, lo); unpack4_fp8(y.y, hi);
#pragma unroll
                    for (int i = 0; i < 4; ++i) { ys[i] += lo[i]; ys[4 + i] += hi[i]; } }
#pragma unroll
                for (int i = 0; i < 8; ++i) v[i] += ys[i] * (1.f / F8_YSCALE);
                u32x4 w; w.x = cvt_pk_bf16(v[0], v[1]); w.y = cvt_pk_bf16(v[2], v[3]); w.z = cvt_pk_bf16(v[4], v[5]); w.w = cvt_pk_bf16(v[6], v[7]);
                *(u32x4*)(X2B + (size_t)t * D + c) = w;
                u32x2 w8; w8.x = pack4_fp8c(v[0] * F8_XSCALE, v[1] * F8_XSCALE, v[2] * F8_XSCALE, v[3] * F8_XSCALE); w8.y = pack4_fp8c(v[4] * F8_XSCALE, v[5] * F8_XSCALE, v[6] * F8_XSCALE, v[7] * F8_XSCALE);
                *(u32x2*)(X2F8 + (size_t)t * D + c) = w8;
#pragma unroll
                for (int i = 0; i < 8; ++i) s += v[i] * v[i];
            }
            s = wave_sum(s);
            if (lane == 0) rstd2[t] = rsqrtf(s * (1.f / D) + RMS_EPS);
          }
#undef CB_LOAD
        }
        __syncthreads();
        pg8::Gemm g{PB, WppT, nullptr, 0, PLE, 0}; pg8::StaticOrder S; S.init(T, D, G, bx);
        pg8::EpiBf16 E{(bf16_t*)(ws + WS_PLEB), D};
        pg8::gemm_phase<pg8::EpiBf16, pg8::StaticOrder, false>(lds + RING_OFF, g, S, E);
    }
    if (IN(10)) {
        pg8::Gemm g{MOE_FP8 ? (const bf16_t*)(ws + WS_X2) : (const bf16_t*)(ws + WS_X2B), WpgT, nullptr, 0, D / (MOE_FP8 ? 2 : 1), 0};
        const bool seam = BOTH(9); auto pre = [&]() { if (seam) xcd_barrier(bar); };
        if (G == 256) {
            pg8::StaticOrder S; S.init(T, D, G, bx, 0, 1 << 30, 4);
            pg8::EpiPleGateNorm E{(const bf16_t*)(ws + WS_X2B), (const float*)(ws + WS_RSTD), (const bf16_t*)(ws + WS_PLEB), args.out, (float*)(ctl + CW_SSQ), (unsigned*)(ctl + CW_PCNT), args.in[21]};
            pg8::gemm_phase<pg8::EpiPleGateNorm, pg8::StaticOrder, false, MOE_FP8 != 0, decltype(pre)>(lds + RING_OFF, g, S, E, pre);
        } else {
            pg8::StaticOrder S; S.init(T, D, G, bx);
            pg8::EpiPleGate E{(const bf16_t*)(ws + WS_X2B), (const float*)(ws + WS_RSTD), (const bf16_t*)(ws + WS_PLEB), XN  , (float*)(ctl + CW_SSQ)};
            pg8::gemm_phase<pg8::EpiPleGate, pg8::StaticOrder, false, MOE_FP8 != 0, decltype(pre)>(lds + RING_OFF, g, S, E, pre);
            if (BOTH(10)) xcd_barrier(bar);
        }
    }
    if (IN(11) && G != 256) {
        const float* ssq = (const float*)(ctl + CW_SSQ);
        for (int m = gw; m < T; m += NGW) {
            const float rr = rsqrtf(ld_agent_f(ssq + m) * (1.f / D) + RMS_EPS);
#pragma unroll
            for (int j = 0; j < 4; ++j) { const size_t c = (size_t)8 * lane + 512 * j; const u32x4 xw = *(const u32x4*)(XN + (size_t)m * D + c);
                const f32x4 g0 = *(const f32x4*)(args.in[21] + c), g1 = *(const f32x4*)(args.in[21] + c + 4);
                f32x4 o0, o1; o0[0] = bflo(xw.x) * rr * g0[0]; o0[1] = bfhi(xw.x) * rr * g0[1]; o0[2] = bflo(xw.y) * rr * g0[2]; o0[3] = bfhi(xw.y) * rr * g0[3];
                o1[0] = bflo(xw.z) * rr * g1[0]; o1[1] = bfhi(xw.z) * rr * g1[1]; o1[2] = bflo(xw.w) * rr * g1[2]; o1[3] = bfhi(xw.w) * rr * g1[3];
                *(f32x4*)(args.out + (size_t)m * D + c) = o0; *(f32x4*)(args.out + (size_t)m * D + c + 4) = o1; }
        }
    }
#undef IN
#undef BOTH
}

static int g_grid = 0;
static void mk(hipStream_t st, const Args& base, int lo, int hi, int li = 0) {
    Args a = base; a.ph_lo = lo; a.ph_hi = hi; a.li = li;
    hipLaunchKernelGGL(mk_fwd, dim3(g_grid), dim3(NWAVES * 64), LDS_BYTES, st, a);
}

extern "C" void kernel_launch(void* const* d_in, const int* in_sizes, int n_in, void* d_out, int out_size, void* d_ws, size_t ws_size, hipStream_t stream) {
    if (g_grid == 0) {
        int dev = 0, cus = 0;
        if (hipGetDevice(&dev) != hipSuccess || hipDeviceGetAttribute(&cus, hipDeviceAttributeMultiprocessorCount, dev) != hipSuccess) { fprintf(stderr, "kernel_launch: device query failed\n"); g_grid = -1; return; }
        if (hipFuncSetAttribute((const void*)mk_fwd, hipFuncAttributeMaxDynamicSharedMemorySize, LDS_BYTES) != hipSuccess) { fprintf(stderr, "kernel_launch: hipFuncSetAttribute failed\n"); g_grid = -1; return; }
        int per_cu = 0;
        if (hipOccupancyMaxActiveBlocksPerMultiprocessor(&per_cu, (const void*)mk_fwd, NWAVES * 64, LDS_BYTES) != hipSuccess || per_cu < 1) fprintf(stderr, "kernel_launch: occupancy query says %d per CU\n", per_cu);
        (void)hipGetLastError();
        g_grid = cus;
    }
    if (g_grid < 0) return;
    if (WS_END > ws_size) { fprintf(stderr, "kernel_launch: workspace too small (%zu)\n", ws_size); return; }
    char* ws = (char*)d_ws; float* out = (float*)d_out;
    Args a{};
    for (int i = 0; i < 22; ++i) a.in[i] = (const float*)d_in[i];
    a.out = out; a.ws = (unsigned char*)d_ws;
    (void)hipMemsetAsync(ws + WS_CTL, 0, CTL_ZERO_BYTES, stream);
    mk(stream, a, 0, 12);
#ifdef PROBE_LO
    for (int r = 1; r <= 3; ++r) mk(stream, a, PROBE_LO, PROBE_HI, r);
#endif
}
```
